# Optimizing an MI355X kernel written in HIP

```python
import jax, jax.numpy as jnp
from jax import lax
import numpy as np

D_MODEL = 1024
BATCH = 16
SEQ = 2048
DEPTH = 2

N_A_LAYERS = DEPTH // 2
N_B_LAYERS = DEPTH - N_A_LAYERS
D_FF = 2816
CHUNK = 128
GMLP_HALF = 2 * D_MODEL
GMLP_GROUPS = 16
GMLP_GROUP_DIM = GMLP_HALF // GMLP_GROUPS
N_HEADS = 8
QK_NOPE = 128
QK_ROPE = 64
V_DIM = 128
KV_RANK = 256
Q_RANK = 512
Q_BLOCK = 128
ROPE_THETA = 10000.0
RMS_EPS = 1e-6
LN_EPS = 1e-5
NEG_INF = -1e30

kernel_name = "yoco_gmlp_mla_macaron_sandwich"


def rms_norm(x, g):
    x32 = x.astype(jnp.float32)
    y = x32 * lax.rsqrt(jnp.mean(x32 * x32, axis=-1, keepdims=True) + RMS_EPS) * g.astype(jnp.float32)
    return y.astype(x.dtype)


def layer_norm(x, g, b):
    x32 = x.astype(jnp.float32)
    mu = jnp.mean(x32, axis=-1, keepdims=True)
    xc = x32 - mu
    y = xc * lax.rsqrt(jnp.mean(xc * xc, axis=-1, keepdims=True) + LN_EPS)
    return (y * g.astype(jnp.float32) + b.astype(jnp.float32)).astype(x.dtype)


def swiglu(n, w_gate, w_up, w_down):
    return (jax.nn.silu(n @ w_gate) * (n @ w_up)) @ w_down


def rope_tables(positions):
    inv_freq = ROPE_THETA ** (-jnp.arange(0, QK_ROPE, 2, dtype=jnp.float32) / QK_ROPE)
    ang = positions.astype(jnp.float32)[..., None] * inv_freq
    return jnp.cos(ang), jnp.sin(ang)


def apply_rope(x, cos, sin):
    cos = cos.astype(x.dtype)
    sin = sin.astype(x.dtype)
    x1, x2 = jnp.split(x, 2, axis=-1)
    return jnp.concatenate([x1 * cos - x2 * sin, x2 * cos + x1 * sin], axis=-1)


def gmlp_mixer(n, w_in, ln_g, ln_b, w_s, b_s, w_out):
    b, s, _ = n.shape
    z = jax.nn.gelu(n @ w_in)
    u, v = jnp.split(z, 2, axis=-1)
    v = layer_norm(v, ln_g, ln_b)
    v = v.reshape(b, s // CHUNK, CHUNK, GMLP_GROUPS, GMLP_GROUP_DIM)
    causal = jnp.tril(jnp.ones((CHUNK, CHUNK), dtype=w_s.dtype))
    w = w_s * causal
    sv = jnp.einsum('gtc,bncgd->bntgd', w, v) + jnp.transpose(b_s)[None, None, :, :, None]
    return (u * sv.reshape(b, s, GMLP_HALF)) @ w_out


def shared_kv(h, kv_norm_g, w_dkv, kv_a_norm_g, w_ukv, cos, sin):
    b, s, _ = h.shape
    n = rms_norm(h, kv_norm_g)
    ckv = n @ w_dkv
    c, k_rope = ckv[..., :KV_RANK], ckv[..., KV_RANK:]
    c = rms_norm(c, kv_a_norm_g)
    k_rope = apply_rope(k_rope, cos, sin)
    kv = (c @ w_ukv).reshape(b, s, N_HEADS, QK_NOPE + V_DIM)
    return kv[..., :QK_NOPE], k_rope, kv[..., QK_NOPE:]


def mla_mixer(n, k_nope, k_rope, v, w_dq, q_norm_g, w_uq, w_o, cos, sin):
    b, s, _ = n.shape
    q = (rms_norm(n @ w_dq, q_norm_g) @ w_uq).reshape(b, s, N_HEADS, QK_NOPE + QK_ROPE)
    q_nope = q[..., :QK_NOPE]
    q_rope = apply_rope(q[..., QK_NOPE:], cos[:, :, None, :], sin[:, :, None, :])
    scale = (QK_NOPE + QK_ROPE) ** -0.5
    outs = []
    for blk in range(s // Q_BLOCK):
        q0, q1 = blk * Q_BLOCK, (blk + 1) * Q_BLOCK
        sc = (jnp.einsum('bqhd,bkhd->bhqk', q_nope[:, q0:q1], k_nope[:, :q1])
              + jnp.einsum('bqhr,bkr->bhqk', q_rope[:, q0:q1], k_rope[:, :q1]))
        sc = sc.astype(jnp.float32) * scale
        q_idx = q0 + jnp.arange(Q_BLOCK)
        k_idx = jnp.arange(q1)
        sc = jnp.where(k_idx[None, :] <= q_idx[:, None], sc, NEG_INF)
        p = jax.nn.softmax(sc, axis=-1).astype(v.dtype)
        outs.append(jnp.einsum('bhqk,bkhd->bqhd', p, v[:, :q1]))
    o = jnp.concatenate(outs, axis=1).reshape(b, s, N_HEADS * V_DIM)
    return o @ w_o


def setup_inputs(seed: int = 0) -> dict:
    key = jax.random.key(seed)
    ks = iter(jax.random.split(key, 40))

    def w(shape, fan_in):
        return jax.random.normal(next(ks), shape, jnp.float32) * (fan_in ** -0.5)

    def g(shape):
        return 1.0 + 0.02 * jax.random.normal(next(ks), shape, jnp.float32)

    x = jax.random.normal(next(ks), (BATCH, SEQ, D_MODEL), jnp.float32)
    offs = jax.random.randint(next(ks), (BATCH, 1), 0, 1024, dtype=jnp.int32)
    positions = (jnp.arange(SEQ, dtype=jnp.int32)[None, :] + offs).astype(jnp.int32)
    return {
        "x": x,
        "positions": positions,
        "ffn_pre_g": g((DEPTH, 2, D_MODEL)),
        "ffn_post_g": g((DEPTH, 2, D_MODEL)),
        "ffn_w_gate": w((DEPTH, 2, D_MODEL, D_FF), D_MODEL),
        "ffn_w_up": w((DEPTH, 2, D_MODEL, D_FF), D_MODEL),
        "ffn_w_down": w((DEPTH, 2, D_FF, D_MODEL), D_FF),
        "mix_pre_g": g((DEPTH, D_MODEL)),
        "mix_post_g": g((DEPTH, D_MODEL)),
        "gmlp_w_in": w((N_A_LAYERS, D_MODEL, 2 * GMLP_HALF), D_MODEL),
        "gmlp_ln_g": g((N_A_LAYERS, GMLP_HALF)),
        "gmlp_ln_b": 0.02 * jax.random.normal(next(ks), (N_A_LAYERS, GMLP_HALF), jnp.float32),
        "gmlp_w_s": w((N_A_LAYERS, GMLP_GROUPS, CHUNK, CHUNK), CHUNK),
        "gmlp_b_s": g((N_A_LAYERS, GMLP_GROUPS, CHUNK)),
        "gmlp_w_out": w((N_A_LAYERS, GMLP_HALF, D_MODEL), GMLP_HALF),
        "kv_norm_g": g((D_MODEL,)),
        "w_dkv": w((D_MODEL, KV_RANK + QK_ROPE), D_MODEL),
        "kv_a_norm_g": g((KV_RANK,)),
        "w_ukv": w((KV_RANK, N_HEADS * (QK_NOPE + V_DIM)), KV_RANK),
        "mla_w_dq": w((N_B_LAYERS, D_MODEL, Q_RANK), D_MODEL),
        "mla_q_norm_g": g((N_B_LAYERS, Q_RANK)),
        "mla_w_uq": w((N_B_LAYERS, Q_RANK, N_HEADS * (QK_NOPE + QK_ROPE)), Q_RANK),
        "mla_w_o": w((N_B_LAYERS, N_HEADS * V_DIM, D_MODEL), N_HEADS * V_DIM),
    }


def reference(x, positions, ffn_pre_g, ffn_post_g, ffn_w_gate, ffn_w_up, ffn_w_down,
              mix_pre_g, mix_post_g, gmlp_w_in, gmlp_ln_g, gmlp_ln_b, gmlp_w_s, gmlp_b_s,
              gmlp_w_out, kv_norm_g, w_dkv, kv_a_norm_g, w_ukv, mla_w_dq, mla_q_norm_g,
              mla_w_uq, mla_w_o):
    cos, sin = rope_tables(positions)
    h = x
    k_nope = k_rope = v = None
    for layer in range(DEPTH):
        f = swiglu(rms_norm(h, ffn_pre_g[layer, 0]), ffn_w_gate[layer, 0], ffn_w_up[layer, 0], ffn_w_down[layer, 0])
        h = h + 0.5 * rms_norm(f, ffn_post_g[layer, 0])
        n = rms_norm(h, mix_pre_g[layer])
        if layer < N_A_LAYERS:
            m = gmlp_mixer(n, gmlp_w_in[layer], gmlp_ln_g[layer], gmlp_ln_b[layer],
                           gmlp_w_s[layer], gmlp_b_s[layer], gmlp_w_out[layer])
        else:
            j = layer - N_A_LAYERS
            m = mla_mixer(n, k_nope, k_rope, v, mla_w_dq[j], mla_q_norm_g[j], mla_w_uq[j], mla_w_o[j], cos, sin)
        h = h + rms_norm(m, mix_post_g[layer])
        f = swiglu(rms_norm(h, ffn_pre_g[layer, 1]), ffn_w_gate[layer, 1], ffn_w_up[layer, 1], ffn_w_down[layer, 1])
        h = h + 0.5 * rms_norm(f, ffn_post_g[layer, 1])
        if layer == N_A_LAYERS - 1:
            k_nope, k_rope, v = shared_kv(h, kv_norm_g, w_dkv, kv_a_norm_g, w_ukv, cos, sin)
    return h
```

```cpp
#include <hip/hip_runtime.h>
#include <hip/hip_cooperative_groups.h>
#include <cstdio>
#include <cstdint>
namespace cg = cooperative_groups;
namespace pg8 {
#define PG8_LAS __attribute__((address_space(3)))
typedef unsigned short bf16_t;
__device__ __forceinline__ int fresh_lane() { int l; asm volatile("v_mbcnt_lo_u32_b32 %0, -1, 0\n\tv_mbcnt_hi_u32_b32 %0, -1, %0" : "=v"(l)); return l; }
typedef short bf16x8 __attribute__((ext_vector_type(8)));
typedef float f32x4 __attribute__((ext_vector_type(4)));
typedef unsigned u32x4 __attribute__((ext_vector_type(4)));
constexpr int BM = 256, BK = 64, HALF = 128, HTB = HALF * BK * 2  , STAGE_BYTES = 8 * HTB, NXCD = 8, WGM = 4;

__host__ __device__ __forceinline__ int lds_byte(int r, int c) { const int st = (r >> 4) * 2 + (c >> 5), rr = r & 15, cc = c & 31, ob = rr * 64 + cc * 2; return st * 1024 + (ob ^ (((ob >> 9) & 1) << 5)); }
__host__ __device__ __forceinline__ void stage_rc(int b, int& R, int& C) { const int st = b / 1024, sb = b % 1024, swz = sb ^ (((sb >> 9) & 1) << 5); R = (st >> 1) * 16 + swz / 64; C = (st & 1) * 32 + (swz % 64) / 2; }
__host__ __device__ __forceinline__ int perm32(int rho) { const int n = rho >> 4, i = rho & 15; return 8 * (i >> 2) + 4 * n + (i & 3); }

struct Unit { int pm, pn; };
struct Gemm { const bf16_t* A; const bf16_t* Bt; int M, N, K; };

struct StaticOrder {
    int nM, nN, nwg, G, c;
    __host__ __device__ void init(int M, int N, int G_, int c_) { nM = M / BM; nN = N / BM; nwg = nM * nN; G = G_; c = c_; }
    __host__ __device__ bool next(int i, Unit& u) const {
        const long L = (long)i * G + c; if (L >= nwg) return false;
        int wgid = (int)L; { const int q = nwg / NXCD, r = nwg % NXCD, xcd = wgid % NXCD, off = wgid / NXCD; wgid = (xcd < r ? xcd * (q + 1) : r * (q + 1) + (xcd - r) * q) + off; }
        const int nig = WGM * nN, gid = wgid / nig, fm = gid * WGM, gsz = (nM - fm) < WGM ? (nM - fm) : WGM;
        u.pm = fm + ((wgid % nig) % gsz); u.pn = (wgid % nig) / gsz; return true;
    }
    __device__ __forceinline__ void a_ready(const Unit&) const {}
    __device__ __forceinline__ void done(const Unit&) const {}
};

__device__ __forceinline__ unsigned cvt_pk_bf16(float lo, float hi) { unsigned r; asm volatile("v_cvt_pk_bf16_f32 %0, %1, %2" : "=v"(r) : "v"(lo), "v"(hi)); return r; }
typedef float f32x2 __attribute__((ext_vector_type(2)));
__device__ __forceinline__ float silu_f(float x) { return x * __builtin_amdgcn_rcpf(1.f + __builtin_amdgcn_exp2f(-1.4426950408889634f * x)); }
__device__ __forceinline__ float gelu_f(float x) { const float t = x * (1.f + 0.044715f * x * x); return x * __builtin_amdgcn_rcpf(1.f + __builtin_amdgcn_exp2f(-2.302208198f * t)); }
__device__ __forceinline__ u32x4 pack8(const f32x4 a, const f32x4 b) { u32x4 w; w.x = cvt_pk_bf16(a[0], a[1]); w.y = cvt_pk_bf16(a[2], a[3]); w.z = cvt_pk_bf16(b[0], b[1]); w.w = cvt_pk_bf16(b[2], b[3]); return w; }
__device__ __forceinline__ float dot4(const f32x4 a) { return (a[0] * a[0] + a[1] * a[1]) + (a[2] * a[2] + a[3] * a[3]); }
__device__ __forceinline__ float sum4(const f32x4 a) { return (a[0] + a[1]) + (a[2] + a[3]); }
__device__ __forceinline__ void rows_rstd(float (&rr)[2][4], const float* part, int row0, int fq) {
    f32x4 v[2][4];
#pragma unroll
    for (int ai = 0; ai < 2; ++ai)
#pragma unroll
        for (int m = 0; m < 4; ++m) v[ai][m] = *(const f32x4*)(part + (size_t)(row0 + ai * HALF + m * 16) * 16 + 4 * fq);
#pragma unroll
    for (int ai = 0; ai < 2; ++ai)
#pragma unroll
        for (int m = 0; m < 4; ++m) { float s = sum4(v[ai][m]); s += __shfl_xor(s, 16); s += __shfl_xor(s, 32); rr[ai][m] = __builtin_amdgcn_rsqf(s * (1.f / 1024.f) + 1e-6f); }
}

struct EpiSwiGLU {
    static constexpr bool PERM = true, AFTER_DRAIN = false;
    bf16_t* O; int ldc; const float* rs;
    __device__ __forceinline__ void operator()(const f32x4 (&acc)[2][2][4][2], const Unit& u, int wr, int wc, int fr, int fq) const {
        const int row0 = u.pm * BM + wr * 64 + fr, col0 = u.pn * 128 + wc * 32 + 8 * fq;
        float rr[2][4]; rows_rstd(rr, rs, row0, fq);
#pragma unroll
        for (int ai = 0; ai < 2; ++ai)
#pragma unroll
            for (int m = 0; m < 4; ++m) {
                const float r = rr[ai][m], rl = -1.4426950408889634f * r, r2 = r * r;
                const f32x4 g0 = acc[ai][0][m][0], g1 = acc[ai][0][m][1];
                f32x4 e0 = g0 * rl, e1 = g1 * rl;
#pragma unroll
                for (int i = 0; i < 4; ++i) { e0[i] = __builtin_amdgcn_exp2f(e0[i]); e1[i] = __builtin_amdgcn_exp2f(e1[i]); }
                e0 = e0 + 1.0f; e1 = e1 + 1.0f;
#pragma unroll
                for (int i = 0; i < 4; ++i) { e0[i] = __builtin_amdgcn_rcpf(e0[i]); e1[i] = __builtin_amdgcn_rcpf(e1[i]); }
                const f32x4 h0 = (g0 * acc[ai][1][m][0]) * (e0 * r2), h1 = (g1 * acc[ai][1][m][1]) * (e1 * r2);
                *(u32x4*)(O + (size_t)(row0 + ai * HALF + m * 16) * ldc + col0) = pack8(h0, h1);
            }
    }
};
struct EpiStat {
    static constexpr bool PERM = true, AFTER_DRAIN = false;
    bf16_t* O; int ldc; float* part; int np; const float* rs;
    __device__ __forceinline__ void operator()(const f32x4 (&acc)[2][2][4][2], const Unit& u, int wr, int wc, int fr, int fq) const {
        const int row0 = u.pm * BM + wr * 64 + fr, col0 = u.pn * BM + wc * 32 + 8 * fq;
        float rr[2][4];
        if (rs) rows_rstd(rr, rs, row0, fq);
#pragma unroll
        for (int ai = 0; ai < 2; ++ai)
#pragma unroll
            for (int m = 0; m < 4; ++m) {
                const int row = row0 + ai * HALF + m * 16; float s = 0.f; const float r = rs ? rr[ai][m] : 1.f;
#pragma unroll
                for (int bj = 0; bj < 2; ++bj) { const f32x4 v0 = acc[ai][bj][m][0] * r, v1 = acc[ai][bj][m][1] * r; s += dot4(v0) + dot4(v1);
                    *(u32x4*)(O + (size_t)row * ldc + col0 + bj * HALF) = pack8(v0, v1); }
                s += __shfl_xor(s, 16); s += __shfl_xor(s, 32);
                if (fq == 0) part[(size_t)row * np + u.pn * 4 + wc] = s;
            }
    }
};
struct EpiGelu {
    static constexpr bool PERM = true, AFTER_DRAIN = false;
    bf16_t* U; bf16_t* V; float* vstat; const float* rs;
    __device__ __forceinline__ void operator()(const f32x4 (&acc)[2][2][4][2], const Unit& u, int wr, int wc, int fr, int fq) const {
        const bool isv = u.pn >= 8; const int pnl = u.pn & 7; bf16_t* base = isv ? V : U;
        const int row0 = u.pm * BM + wr * 64 + fr, col0 = pnl * BM + wc * 32 + 8 * fq;
        float rr[2][4]; rows_rstd(rr, rs, row0, fq);
#pragma unroll
        for (int ai = 0; ai < 2; ++ai)
#pragma unroll
            for (int m = 0; m < 4; ++m) {
                const int row = row0 + ai * HALF + m * 16; float s1 = 0.f, s2 = 0.f; const float r = rr[ai][m];
#pragma unroll
                for (int bj = 0; bj < 2; ++bj) {
                    const f32x4 x0 = acc[ai][bj][m][0] * r, x1 = acc[ai][bj][m][1] * r;
                    f32x4 e0 = (x0 * x0 * 0.044715f + 1.0f) * (x0 * -2.302208198f), e1 = (x1 * x1 * 0.044715f + 1.0f) * (x1 * -2.302208198f);
#pragma unroll
                    for (int i = 0; i < 4; ++i) { e0[i] = __builtin_amdgcn_exp2f(e0[i]); e1[i] = __builtin_amdgcn_exp2f(e1[i]); }
                    e0 = e0 + 1.0f; e1 = e1 + 1.0f;
#pragma unroll
                    for (int i = 0; i < 4; ++i) { e0[i] = __builtin_amdgcn_rcpf(e0[i]); e1[i] = __builtin_amdgcn_rcpf(e1[i]); }
                    const f32x4 v0 = x0 * e0, v1 = x1 * e1;
                    s1 += sum4(v0) + sum4(v1); s2 += dot4(v0) + dot4(v1);
                    *(u32x4*)(base + (size_t)row * 2048 + col0 + bj * HALF) = pack8(v0, v1); }
                if (isv) { s1 += __shfl_xor(s1, 16); s1 += __shfl_xor(s1, 32); s2 += __shfl_xor(s2, 16); s2 += __shfl_xor(s2, 32);
                    if (fq == 0) { f32x2 st; st.x = s1; st.y = s2; *(f32x2*)(vstat + ((size_t)row * 32 + pnl * 4 + wc) * 2) = st; } }
            }
    }
};
struct EpiDkv {
    static constexpr bool PERM = true, AFTER_DRAIN = false;
    bf16_t* C; float* cpart; bf16_t* KR; const float* cs; const float* sn; const float* rs;
    __device__ __forceinline__ void operator()(const f32x4 (&acc)[2][2][4][2], const Unit& u, int wr, int wc, int fr, int fq) const {
        const int row0 = u.pm * BM + wr * 64 + fr;
        float rr[2][4]; rows_rstd(rr, rs, row0, fq);
        if (u.pn == 0) {
            const int col0 = wc * 32 + 8 * fq;
#pragma unroll
            for (int ai = 0; ai < 2; ++ai)
#pragma unroll
                for (int m = 0; m < 4; ++m) {
                    const int row = row0 + ai * HALF + m * 16; float s = 0.f; const float r = rr[ai][m];
#pragma unroll
                    for (int bj = 0; bj < 2; ++bj) { const f32x4 v0 = acc[ai][bj][m][0] * r, v1 = acc[ai][bj][m][1] * r; s += dot4(v0) + dot4(v1);
                        *(u32x4*)(C + (size_t)row * 256 + col0 + bj * HALF) = pack8(v0, v1); }
                    s += __shfl_xor(s, 16); s += __shfl_xor(s, 32);
                    if (fq == 0) cpart[(size_t)row * 4 + wc] = s;
                }
        } else if (wc == 0) {
#pragma unroll
            for (int ai = 0; ai < 2; ++ai)
#pragma unroll
                for (int m = 0; m < 4; ++m) {
                    const int row = row0 + ai * HALF + m * 16;
                    const f32x4 c0 = *(const f32x4*)(cs + (size_t)row * 32 + 8 * fq), c1 = *(const f32x4*)(cs + (size_t)row * 32 + 8 * fq + 4);
                    const f32x4 s0 = *(const f32x4*)(sn + (size_t)row * 32 + 8 * fq), s1 = *(const f32x4*)(sn + (size_t)row * 32 + 8 * fq + 4);
                    const float r = rr[ai][m];
                    const f32x4 a0 = acc[ai][0][m][0] * r, a1 = acc[ai][0][m][1] * r, b0 = acc[ai][1][m][0] * r, b1 = acc[ai][1][m][1] * r;
                    *(u32x4*)(KR + (size_t)row * 64 + 8 * fq) = pack8(a0 * c0 - b0 * s0, a1 * c1 - b1 * s1);
                    *(u32x4*)(KR + (size_t)row * 64 + 32 + 8 * fq) = pack8(b0 * c0 + a0 * s0, b1 * c1 + a1 * s1);
                    asm volatile("" ::: "memory");
                }
        }
    }
};
struct PanelSS {
    unsigned* xbuf; unsigned tag;
    __device__ __forceinline__ void run(const f32x4 (&v)[2][2][4][2], const Unit& u, int wr, int wc, int fr, int fq, PG8_LAS unsigned char* tab) const {
        PG8_LAS float* P = (PG8_LAS float*)tab; PG8_LAS float* S = (PG8_LAS float*)(tab + 4096);
        const int wid = wr * 4 + wc, lane = fq * 16 + fr;
#pragma unroll
        for (int ai = 0; ai < 2; ++ai)
#pragma unroll
            for (int m = 0; m < 4; ++m) { float s = 0.f;
#pragma unroll
                for (int bj = 0; bj < 2; ++bj) s += dot4(v[ai][bj][m][0]) + dot4(v[ai][bj][m][1]);
                s += __shfl_xor(s, 16); s += __shfl_xor(s, 32);
                if (fq == 0) P[(ai * HALF + wr * 64 + m * 16 + fr) * 4 + wc] = s; }
        asm volatile("s_waitcnt lgkmcnt(0)" ::: "memory"); __builtin_amdgcn_s_barrier(); asm volatile("" ::: "memory");
        const int row = wid * 32 + (lane & 31);
        if (lane < 32) {
            const float t = (P[row * 4] + P[row * 4 + 1]) + (P[row * 4 + 2] + P[row * 4 + 3]);
            unsigned* slot = xbuf + (size_t)(u.pm * BM + row) * 4;
            __hip_atomic_store(slot + u.pn, (__float_as_uint(t) & ~7u) | tag, __ATOMIC_RELAXED, __HIP_MEMORY_SCOPE_AGENT);
            unsigned w0, w1, w2, w3; int it = 0;
            for (;;) {
                w0 = __hip_atomic_load(slot + 0, __ATOMIC_RELAXED, __HIP_MEMORY_SCOPE_AGENT); w1 = __hip_atomic_load(slot + 1, __ATOMIC_RELAXED, __HIP_MEMORY_SCOPE_AGENT);
                w2 = __hip_atomic_load(slot + 2, __ATOMIC_RELAXED, __HIP_MEMORY_SCOPE_AGENT); w3 = __hip_atomic_load(slot + 3, __ATOMIC_RELAXED, __HIP_MEMORY_SCOPE_AGENT);
                const bool ok = ((w0 & 7u) == tag) & ((w1 & 7u) == tag) & ((w2 & 7u) == tag) & ((w3 & 7u) == tag);
                if (ok || ++it > 400000) break;
                __builtin_amdgcn_s_sleep(1);
            }
            S[row] = (__uint_as_float(w0 & ~7u) + __uint_as_float(w1 & ~7u)) + (__uint_as_float(w2 & ~7u) + __uint_as_float(w3 & ~7u));
        }
        asm volatile("s_waitcnt vmcnt(0) lgkmcnt(0)" ::: "memory"); __builtin_amdgcn_s_barrier(); asm volatile("" ::: "memory");
    }
};
__device__ __forceinline__ float bf_lo(unsigned w) { return __uint_as_float(w << 16); }
__device__ __forceinline__ float bf_hi(unsigned w) { return __uint_as_float(w & 0xffff0000u); }
template <bool FINAL> struct EpiRes {
    static constexpr bool PERM = true, AFTER_DRAIN = false;
    bf16_t* HB; const float* gpost; float coef; float* part; float* out; PanelSS ss; PG8_LAS unsigned char* tab;
    __device__ __forceinline__ void operator()(const f32x4 (&acc)[2][2][4][2], const Unit& u, int wr, int wc, int fr, int fq) const {
        const int row0 = u.pm * BM + wr * 64 + fr, col0 = u.pn * BM + wc * 32 + 8 * fq;
        u32x4 pre[4][2];
#pragma unroll
        for (int m = 0; m < 4; ++m)
#pragma unroll
            for (int bj = 0; bj < 2; ++bj) pre[m][bj] = *(const u32x4*)(HB + (size_t)(row0 + m * 16) * 1024 + col0 + bj * HALF);
        f32x4 g[2][2];
#pragma unroll
        for (int bj = 0; bj < 2; ++bj) { g[bj][0] = *(const f32x4*)(gpost + col0 + bj * HALF); g[bj][1] = *(const f32x4*)(gpost + col0 + bj * HALF + 4); }
        ss.run(acc, u, wr, wc, fr, fq, tab);
        u32x4 post[4][2];
#pragma unroll
        for (int m = 0; m < 4; ++m)
#pragma unroll
            for (int bj = 0; bj < 2; ++bj) post[m][bj] = *(const u32x4*)(HB + (size_t)(row0 + HALF + m * 16) * 1024 + col0 + bj * HALF);
        const PG8_LAS float* S = (const PG8_LAS float*)(tab + 4096);
#pragma unroll
        for (int ai = 0; ai < 2; ++ai)
#pragma unroll
            for (int m = 0; m < 4; ++m) {
                const int rl = ai * HALF + wr * 64 + m * 16 + fr, row = u.pm * BM + rl;
                const float rf = __builtin_amdgcn_rsqf(S[rl] * (1.f / 1024.f) + 1e-6f) * coef; float s2 = 0.f;
#pragma unroll
                for (int bj = 0; bj < 2; ++bj) {
                    const u32x4 hw = (ai == 0) ? pre[m][bj] : post[m][bj];
                    f32x4 h0, h1; h0[0] = bf_lo(hw.x); h0[1] = bf_hi(hw.x); h0[2] = bf_lo(hw.y); h0[3] = bf_hi(hw.y); h1[0] = bf_lo(hw.z); h1[1] = bf_hi(hw.z); h1[2] = bf_lo(hw.w); h1[3] = bf_hi(hw.w);
                    h0 = h0 + acc[ai][bj][m][0] * g[bj][0] * rf; h1 = h1 + acc[ai][bj][m][1] * g[bj][1] * rf;
                    if (FINAL) { __builtin_nontemporal_store(h0, (f32x4*)(out + (size_t)row * 1024 + col0 + bj * HALF)); __builtin_nontemporal_store(h1, (f32x4*)(out + (size_t)row * 1024 + col0 + bj * HALF + 4)); }
                    else { s2 += dot4(h0) + dot4(h1); *(u32x4*)(HB + (size_t)row * 1024 + col0 + bj * HALF) = pack8(h0, h1); }
                }
                if (!FINAL) { s2 += __shfl_xor(s2, 16); s2 += __shfl_xor(s2, 32); if (fq == 0) part[(size_t)row * 16 + u.pn * 4 + wc] = s2; }
            }
    }
};

struct EpiUkv {
    static constexpr bool PERM = true, AFTER_DRAIN = false;
    bf16_t* KN; bf16_t* VV; const float* cpart;
    __device__ __forceinline__ void operator()(const f32x4 (&acc)[2][2][4][2], const Unit& u, int wr, int wc, int fr, int fq) const {
        const int row0 = u.pm * BM + wr * 64 + fr, col0 = u.pn * 128 + wc * 32 + 8 * fq;
#pragma unroll
        for (int ai = 0; ai < 2; ++ai)
#pragma unroll
            for (int m = 0; m < 4; ++m) {
                const int row = row0 + ai * HALF + m * 16;
                const f32x4 cp = *(const f32x4*)(cpart + (size_t)row * 4);
                const float rc = __builtin_amdgcn_rsqf(sum4(cp) * (1.f / 256.f) + 1e-6f);
                *(u32x4*)(KN + (size_t)row * 1024 + col0) = pack8(acc[ai][0][m][0] * rc, acc[ai][0][m][1] * rc);
                *(u32x4*)(VV + (size_t)row * 1024 + col0) = pack8(acc[ai][1][m][0] * rc, acc[ai][1][m][1] * rc);
                asm volatile("" ::: "memory");
            }
    }
};
struct EpiUq {
    static constexpr bool PERM = true, AFTER_DRAIN = false;
    bf16_t* Q; const float* qpart; const float* cs; const float* sn;
    __device__ __forceinline__ void operator()(const f32x4 (&acc)[2][2][4][2], const Unit& u, int wr, int wc, int fr, int fq) const {
        const int row0 = u.pm * BM + wr * 64 + fr;
#pragma unroll
        for (int ai = 0; ai < 2; ++ai)
#pragma unroll
            for (int m = 0; m < 4; ++m) {
                const int row = row0 + ai * HALF + m * 16;
                const f32x4 p0 = *(const f32x4*)(qpart + (size_t)row * 8), p1 = *(const f32x4*)(qpart + (size_t)row * 8 + 4);
                const float rq = __builtin_amdgcn_rsqf((sum4(p0) + sum4(p1)) * (1.f / 512.f) + 1e-6f);
                bf16_t* qrow = Q + (size_t)row * 1536;
                if (u.pn < 4) {
#pragma unroll
                    for (int bj = 0; bj < 2; ++bj) *(u32x4*)(qrow + (2 * u.pn + bj) * 192 + wc * 32 + 8 * fq) = pack8(acc[ai][bj][m][0] * rq, acc[ai][bj][m][1] * rq);
                } else {
                    const int head = 4 * (u.pn - 4) + wc;
                    const f32x4 c0 = *(const f32x4*)(cs + (size_t)row * 32 + 8 * fq), c1 = *(const f32x4*)(cs + (size_t)row * 32 + 8 * fq + 4);
                    const f32x4 s0 = *(const f32x4*)(sn + (size_t)row * 32 + 8 * fq), s1 = *(const f32x4*)(sn + (size_t)row * 32 + 8 * fq + 4);
                    const f32x4 a0 = acc[ai][0][m][0] * rq, a1 = acc[ai][0][m][1] * rq, b0 = acc[ai][1][m][0] * rq, b1 = acc[ai][1][m][1] * rq;
                    *(u32x4*)(qrow + head * 192 + 128 + 8 * fq) = pack8(a0 * c0 - b0 * s0, a1 * c1 - b1 * s1);
                    *(u32x4*)(qrow + head * 192 + 160 + 8 * fq) = pack8(b0 * c0 + a0 * s0, b1 * c1 + a1 * s1);
                }
                asm volatile("" ::: "memory");
            }
    }
};

template <class Epi, class Sched, bool ALIGN_EPI = false, bool SP2 = false>
__device__ __forceinline__ void gemm_phase(PG8_LAS unsigned char* lds, const Gemm g, const Sched& S, const Epi& E, const int wv) {
    int tid_ = (wv << 6) | fresh_lane();
    const int tid = tid_, wid = __builtin_amdgcn_readfirstlane(tid >> 6), lane = tid & 63, wr = wid >> 2, wc = wid & 3, fr = lane & 15, fq = lane >> 4;
    const int K = g.K, nt = K / BK;
    unsigned voffA[2], voffB[2];
#pragma unroll
    for (int i = 0; i < 2; ++i) { int R, C; stage_rc(tid * 16 + i * 8192, R, C); const int Rb = Epi::PERM ? ((R & ~31) + perm32(R & 31)) : R;
        voffA[i] = (unsigned)(R * K + C) * 2u; voffB[i] = (unsigned)(Rb * K + C) * 2u; }
    const size_t kstep = (size_t)(BK * 2);
    const size_t hstep = (size_t)HALF * K * 2;
    const size_t tstep = 2 * hstep;
    const unsigned ldsw = (unsigned)wid * 1024u;
    const int aoff = lds_byte(wr * 64 + fr, fq * 8), boff = lds_byte(wc * 32 + fr, fq * 8);
#define PG8_SA(b, h) (((b) * 2 + (h)) * HTB)
#define PG8_SB(b, h) ((4 + (b) * 2 + (h)) * HTB)
#define PG8_STAGE(bufoff, gbase, voff) do { _Pragma("unroll") for (int _i = 0; _i < 2; ++_i) \
        __builtin_amdgcn_global_load_lds((const unsigned*)((const char*)(gbase) + (voff)[_i]), (PG8_LAS unsigned*)(lds + (bufoff) + ldsw + _i * 8192), 16, 0, 0); } while (0)
#define PG8_LDA(dst, b, h) do { _Pragma("unroll") for (int m = 0; m < 4; ++m) _Pragma("unroll") for (int k = 0; k < 2; ++k) dst[m][k] = *(const PG8_LAS bf16x8*)(lds + PG8_SA(b, h) + aoff + m * 2048 + k * 1024); } while (0)
#define PG8_LDB(dst, b, h) do { _Pragma("unroll") for (int n = 0; n < 2; ++n) _Pragma("unroll") for (int k = 0; k < 2; ++k) dst[n][k] = *(const PG8_LAS bf16x8*)(lds + PG8_SB(b, h) + boff + n * 2048 + k * 1024); } while (0)
#define PG8_MMA(ai, bj, At, Bt) do { __builtin_amdgcn_s_setprio(1); _Pragma("unroll") for (int m = 0; m < 4; ++m) _Pragma("unroll") for (int n = 0; n < 2; ++n) _Pragma("unroll") for (int k = 0; k < 2; ++k) \
        acc[ai][bj][m][n] = __builtin_amdgcn_mfma_f32_16x16x32_bf16(Bt[n][k], At[m][k], acc[ai][bj][m][n], 0, 0, 0); __builtin_amdgcn_s_setprio(0); } while (0)
#define PG8_WAIT_V(n) asm volatile("s_waitcnt vmcnt(" #n ")" ::: "memory")
#define PG8_WAIT_L(n) asm volatile("s_waitcnt lgkmcnt(" #n ")" ::: "memory")
#define PG8_BAR __builtin_amdgcn_s_barrier()
#define PG8_SCHED __builtin_amdgcn_sched_barrier(0)
    Unit cur, nxt; int ui = 0;
    if (!S.next(0, cur)) return;
    f32x4 acc[2][2][4][2];
#pragma unroll
    for (int a = 0; a < 2; ++a)
#pragma unroll
        for (int b = 0; b < 2; ++b)
#pragma unroll
            for (int m = 0; m < 4; ++m)
#pragma unroll
                for (int n = 0; n < 2; ++n) acc[a][b][m][n] = (f32x4){0.f, 0.f, 0.f, 0.f};
    bf16x8 At[4][2], B0[2][2], B1[2][2];
    const char* cA = (const char*)g.A + (size_t)cur.pm * tstep; const char* cB = (const char*)g.Bt + (size_t)cur.pn * tstep;
    S.a_ready(cur);
    if constexpr (SP2) {
        PG8_STAGE(PG8_SB(0, 0), cB, voffB); PG8_STAGE(PG8_SB(0, 1), cB + hstep, voffB); PG8_STAGE(PG8_SA(0, 0), cA, voffA); PG8_STAGE(PG8_SA(0, 1), cA + hstep, voffA);
        if (wr == 1) PG8_BAR;
        PG8_WAIT_V(2); PG8_BAR;
        PG8_STAGE(PG8_SB(1, 0), cB + kstep, voffB); PG8_STAGE(PG8_SA(1, 0), cA + kstep, voffA); PG8_STAGE(PG8_SB(1, 1), cB + hstep + kstep, voffB);
        PG8_WAIT_V(6); PG8_BAR;
    } else {
        PG8_STAGE(PG8_SB(0, 0), cB, voffB); PG8_STAGE(PG8_SA(0, 0), cA, voffA); PG8_STAGE(PG8_SB(0, 1), cB + hstep, voffB); PG8_STAGE(PG8_SA(0, 1), cA + hstep, voffA);
        if (wr == 1) PG8_BAR;
        PG8_WAIT_V(4); PG8_BAR;
        PG8_STAGE(PG8_SB(1, 0), cB + kstep, voffB); PG8_STAGE(PG8_SA(1, 0), cA + kstep, voffA); PG8_STAGE(PG8_SB(1, 1), cB + hstep + kstep, voffB);
        PG8_WAIT_V(6); PG8_BAR;
    }
    for (;;) {
        const bool has_next = S.next(ui + 1, nxt);
        const char* nA = has_next ? (const char*)g.A + (size_t)nxt.pm * tstep : cA; const char* nB = has_next ? (const char*)g.Bt + (size_t)nxt.pn * tstep : cB;
        for (int t = 0; t < nt; t += 2) {
            const bool last = (t == nt - 2);
            const char* a1 = cA + (size_t)(t + 1) * kstep;
            const char* a2 = last ? nA : cA + (size_t)(t + 2) * kstep; const char* b2 = last ? nB : cB + (size_t)(t + 2) * kstep;
            const char* a3 = a2 + kstep; const char* b3 = b2 + kstep;
            if (last && has_next) S.a_ready(nxt);
            if constexpr (SP2) {
            PG8_LDB(B0, 0, 0); PG8_LDB(B1, 0, 1); PG8_SCHED; PG8_LDA(At, 0, 0); PG8_STAGE(PG8_SA(1, 1), a1 + hstep, voffA);
            PG8_WAIT_V(8); PG8_WAIT_L(0); PG8_BAR; PG8_MMA(0, 0, At, B0); PG8_MMA(0, 1, At, B1); PG8_BAR; PG8_SCHED;
            PG8_LDA(At, 0, 1); PG8_STAGE(PG8_SB(0, 0), b2, voffB); PG8_STAGE(PG8_SB(0, 1), b2 + hstep, voffB); PG8_STAGE(PG8_SA(0, 0), a2, voffA);
            PG8_WAIT_V(8); PG8_WAIT_L(0); PG8_BAR; PG8_MMA(1, 0, At, B0); PG8_MMA(1, 1, At, B1); PG8_BAR; PG8_SCHED;
            PG8_LDB(B0, 1, 0); PG8_LDB(B1, 1, 1); PG8_SCHED; PG8_LDA(At, 1, 0); PG8_STAGE(PG8_SA(0, 1), a2 + hstep, voffA);
            PG8_WAIT_V(8); PG8_WAIT_L(0); PG8_BAR; PG8_MMA(0, 0, At, B0); PG8_MMA(0, 1, At, B1); PG8_BAR; PG8_SCHED;
            PG8_LDA(At, 1, 1); PG8_STAGE(PG8_SB(1, 0), b3, voffB); PG8_STAGE(PG8_SB(1, 1), b3 + hstep, voffB); PG8_STAGE(PG8_SA(1, 0), a3, voffA);
            PG8_WAIT_V(8); PG8_WAIT_L(0); PG8_BAR; PG8_MMA(1, 0, At, B0); PG8_MMA(1, 1, At, B1); PG8_BAR; PG8_SCHED;
            } else {
            PG8_LDB(B0, 0, 0); PG8_SCHED; PG8_LDA(At, 0, 0); PG8_STAGE(PG8_SA(1, 1), a1 + hstep, voffA);
            PG8_WAIT_L(8); PG8_BAR; PG8_WAIT_L(0); PG8_MMA(0, 0, At, B0); PG8_BAR; PG8_SCHED;
            PG8_LDB(B1, 0, 1); PG8_STAGE(PG8_SB(0, 0), b2, voffB);
            PG8_BAR; PG8_WAIT_L(0); PG8_MMA(0, 1, At, B1); PG8_BAR;
            PG8_LDA(At, 0, 1); PG8_STAGE(PG8_SA(0, 0), a2, voffA);
            PG8_BAR; PG8_WAIT_L(0); PG8_MMA(1, 0, At, B0); PG8_BAR; PG8_SCHED;
            PG8_STAGE(PG8_SB(0, 1), b2 + hstep, voffB);
            PG8_WAIT_V(6); PG8_BAR; PG8_MMA(1, 1, At, B1); PG8_BAR;
            PG8_LDB(B0, 1, 0); PG8_SCHED; PG8_LDA(At, 1, 0); PG8_STAGE(PG8_SA(0, 1), a2 + hstep, voffA);
            PG8_WAIT_L(8); PG8_BAR; PG8_WAIT_L(0); PG8_MMA(0, 0, At, B0); PG8_BAR; PG8_SCHED;
            PG8_LDB(B1, 1, 1); PG8_STAGE(PG8_SB(1, 0), b3, voffB);
            PG8_BAR; PG8_WAIT_L(0); PG8_MMA(0, 1, At, B1); PG8_BAR;
            PG8_LDA(At, 1, 1); PG8_STAGE(PG8_SA(1, 0), a3, voffA);
            PG8_BAR; PG8_WAIT_L(0); PG8_MMA(1, 0, At, B0); PG8_BAR; PG8_SCHED;
            PG8_STAGE(PG8_SB(1, 1), b3 + hstep, voffB);
            PG8_WAIT_V(6); PG8_BAR; PG8_MMA(1, 1, At, B1); PG8_BAR;
            }
        }
        if constexpr (ALIGN_EPI) { if (wr == 0) PG8_BAR; }
        if constexpr (!Epi::AFTER_DRAIN) { E(acc, cur, wr, wc, fr, fq); S.done(cur); }
        if (!has_next) break;
#pragma unroll
        for (int a = 0; a < 2; ++a)
#pragma unroll
            for (int b = 0; b < 2; ++b)
#pragma unroll
                for (int m = 0; m < 4; ++m)
#pragma unroll
                    for (int n = 0; n < 2; ++n) acc[a][b][m][n] = (f32x4){0.f, 0.f, 0.f, 0.f};
        cur = nxt; cA = nA; cB = nB; ++ui;
        if constexpr (ALIGN_EPI) { if (wr == 1) PG8_BAR; }
    }
    PG8_WAIT_V(0);
    if constexpr (!ALIGN_EPI) { if (wr == 0) PG8_BAR; }
    PG8_BAR;
    if constexpr (Epi::AFTER_DRAIN) { E.fused(acc, cur, wr, wc, fr, fq, lds, wid, lane); S.done(cur); }
#undef PG8_SA
#undef PG8_SB
#undef PG8_STAGE
#undef PG8_LDA
#undef PG8_LDB
#undef PG8_MMA
#undef PG8_WAIT_V
#undef PG8_WAIT_L
#undef PG8_BAR
#undef PG8_SCHED
}
}

#define LAS __attribute__((address_space(3)))
typedef unsigned short bf16;
typedef unsigned v4u __attribute__((ext_vector_type(4)));
typedef unsigned v2u __attribute__((ext_vector_type(2)));
typedef float f32x4 __attribute__((ext_vector_type(4)));
typedef float f32x16 __attribute__((ext_vector_type(16)));
typedef short bf16x8 __attribute__((ext_vector_type(8)));
typedef short s16x4 __attribute__((ext_vector_type(4)));

constexpr int NWAVES = 8, NTHREADS = 512;
constexpr int T = 32768, D = 1024, FF = 2816, SEQ = 2048, NB = 16;
constexpr int LDS_BYTES = 147456;
constexpr size_t MiB = 1u << 20;
constexpr size_t WS_WGU = 0, WS_WD = 44 * MiB, WS_WIN = 66 * MiB, WS_WOUT = 74 * MiB, WS_WDKV = 78 * MiB, WS_WUKV = 79 * MiB, WS_WDQ = 80 * MiB, WS_WUQ = 81 * MiB, WS_WO = 83 * MiB, WS_WSM = 85 * MiB;
constexpr size_t WS_HNF = 88 * MiB;
constexpr size_t WS_BIG = 152 * MiB;
constexpr size_t WS_HID = WS_BIG;
constexpr size_t WS_U = WS_BIG, WS_V = WS_BIG + 128 * MiB;
constexpr size_t WS_Q = WS_BIG, WS_QC = WS_BIG + 96 * MiB, WS_O = WS_BIG + 128 * MiB;
constexpr size_t WS_C = 328 * MiB;
constexpr size_t WS_KN = 344 * MiB, WS_VV = 408 * MiB, WS_KR = 472 * MiB;
constexpr size_t WS_PART = 476 * MiB, WS_VSTAT = 478 * MiB, WS_CPART = 486 * MiB, WS_QPART = 487 * MiB, WS_COS = 488 * MiB, WS_SIN = 492 * MiB, WS_BAR = 496 * MiB, WS_XBUF = 496 * MiB + 131072, WS_END = 497 * MiB;
constexpr size_t WGU_ELEMS = (size_t)2 * FF * D, WD_ELEMS = (size_t)D * FF;

__device__ __forceinline__ float wave_sum(float v) {
#pragma unroll
    for (int o = 1; o < 64; o <<= 1) v += __shfl_xor(v, o);
    return v;
}
__device__ __forceinline__ float bf2f(unsigned short b) { return __uint_as_float(((unsigned)b) << 16); }
__device__ __forceinline__ float bflo(unsigned w) { return __uint_as_float(w << 16); }
__device__ __forceinline__ float bfhi(unsigned w) { return __uint_as_float(w & 0xffff0000u); }
__device__ __forceinline__ unsigned pk2(float lo, float hi) { return pg8::cvt_pk_bf16(lo, hi); }

__device__ __forceinline__ int map_row(int kind, int n) {
    if (kind == 0) return n;
    if (kind == 1) return 256 * (n >> 7) + (n & 127);
    if (kind == 2) return 256 * (n >> 7) + 128 + (n & 127);
    if (kind == 3) { if (n < 256) return n; const int i = n - 256; return 256 + 128 * (i >> 5) + (i & 31); }
    { const int h = n / 192, j = n - h * 192; if (j < 128) return h * 128 + j; const int i = j - 128; return 1024 + 256 * (h >> 2) + 128 * (i >> 5) + 32 * (h & 3) + (i & 31); }
}
__device__ __forceinline__ void transpose_item(const float* W, int K, int N, const float* gain, float scale, bf16* WT, int kind, LAS float* scr, int item, int lane) {
    const int nblk = N / 64, kb = item / nblk, nb = item % nblk, k0 = 64 * kb, n0 = 64 * nb;
    f32x4 v[16];
#pragma unroll
    for (int i = 0; i < 16; ++i) v[i] = __builtin_nontemporal_load((const f32x4*)(W + (size_t)(k0 + 4 * i + (lane >> 4)) * N + n0 + 4 * (lane & 15)));
#pragma unroll
    for (int i = 0; i < 16; ++i) { const int kk = 4 * i + (lane >> 4); const float gk = gain ? gain[k0 + kk] * scale : scale; LAS float* d = scr + kk * 65 + 4 * (lane & 15);
        d[0] = v[i][0] * gk; d[1] = v[i][1] * gk; d[2] = v[i][2] * gk; d[3] = v[i][3] * gk; }
    asm volatile("s_waitcnt lgkmcnt(0)" ::: "memory");
    const int c = lane & 7;
#pragma unroll
    for (int j = 0; j < 8; ++j) { const int n = (lane >> 3) + 8 * j; const LAS float* s = scr + (8 * c) * 65 + n;
        v4u o; o.x = pk2(s[0 * 65], s[1 * 65]); o.y = pk2(s[2 * 65], s[3 * 65]); o.z = pk2(s[4 * 65], s[5 * 65]); o.w = pk2(s[6 * 65], s[7 * 65]);
        __builtin_nontemporal_store(o, (v4u*)(WT + (size_t)map_row(kind, n0 + n) * K + k0 + 8 * c)); }
    asm volatile("s_waitcnt lgkmcnt(0)" ::: "memory");
}

struct Params { const float* in[23]; float* out; unsigned char* ws; };

template <int MODE>
__device__ __forceinline__ void row_pass(const float* x, bf16* hb, const bf16* f, const float* part, const float* gpost, float coef, float* rs, float* out, const int wv) {
    int tid_ = (wv << 6) | pg8::fresh_lane(); const int lane = tid_ & 63, gw = blockIdx.x * NWAVES + __builtin_amdgcn_readfirstlane(tid_ >> 6), NGW = gridDim.x * NWAVES;
    for (int row = gw; row < T; row += NGW) {
        f32x4 hv[4];
        if (MODE == 0) {
#pragma unroll
            for (int j = 0; j < 4; ++j) hv[j] = __builtin_nontemporal_load((const f32x4*)(x + (size_t)row * D + 256 * j + 4 * lane));
        } else {
            const f32x4 p0 = *(const f32x4*)(part + (size_t)row * 16), p1 = *(const f32x4*)(part + (size_t)row * 16 + 4), p2 = *(const f32x4*)(part + (size_t)row * 16 + 8), p3 = *(const f32x4*)(part + (size_t)row * 16 + 12);
            const float ssf = (pg8::sum4(p0) + pg8::sum4(p1)) + (pg8::sum4(p2) + pg8::sum4(p3));
            const float rf = __builtin_amdgcn_rsqf(ssf * (1.f / D) + 1e-6f) * coef;
#pragma unroll
            for (int j = 0; j < 4; ++j) {
                const v2u hw = *(const v2u*)(hb + (size_t)row * D + 256 * j + 4 * lane);
                const v2u fw = *(const v2u*)(f + (size_t)row * D + 256 * j + 4 * lane);
                const f32x4 g = *(const f32x4*)(gpost + 256 * j + 4 * lane);
                f32x4 fv, h0; fv[0] = bflo(fw.x); fv[1] = bfhi(fw.x); fv[2] = bflo(fw.y); fv[3] = bfhi(fw.y); h0[0] = bflo(hw.x); h0[1] = bfhi(hw.x); h0[2] = bflo(hw.y); h0[3] = bfhi(hw.y);
                hv[j] = h0 + fv * g * rf;
            }
        }
        if (MODE == 2) {
#pragma unroll
            for (int j = 0; j < 4; ++j) *(f32x4*)(out + (size_t)row * D + 256 * j + 4 * lane) = hv[j];
        } else {
            float ss = 0.f;
#pragma unroll
            for (int j = 0; j < 4; ++j) ss += pg8::dot4(hv[j]);
            ss = wave_sum(ss);
            if (lane < 16) rs[(size_t)row * 16 + lane] = lane == 0 ? ss : 0.f;
#pragma unroll
            for (int j = 0; j < 4; ++j) { v2u o; o.x = pk2(hv[j][0], hv[j][1]); o.y = pk2(hv[j][2], hv[j][3]); *(v2u*)(hb + (size_t)row * D + 256 * j + 4 * lane) = o; }
        }
    }
}

__device__ __forceinline__ void prologue(const Params& p, LAS unsigned char* lds, const int wv) {
    int tid_ = (wv << 6) | pg8::fresh_lane(); const int lane = tid_ & 63, wave = __builtin_amdgcn_readfirstlane(tid_ >> 6), gw = blockIdx.x * NWAVES + wave, NGW = gridDim.x * NWAVES;
    unsigned char* ws = p.ws;
    LAS float* scr = (LAS float*)(lds + wave * 16640);
    {
        constexpr int I_FF = (D / 64) * (FF / 64);
        constexpr int C0 = 4 * I_FF, C1 = 8 * I_FF, C2 = 12 * I_FF, C3 = C2 + 16 * 64, C4 = C3 + 32 * 16, C5 = C4 + 16 * 5, C6 = C5 + 4 * 32, C7 = C6 + 16 * 8, C8 = C7 + 8 * 24, C9 = C8 + 16 * 16;
        for (int it = gw; it < C9; it += NGW) {
            const float* W; const float* gain = nullptr; bf16* dst; int K, N, kind = 0, li; float scale = 1.f;
            if (it < C0)      { const int j = it / I_FF; li = it - j * I_FF; W = p.in[4] + (size_t)j * D * FF; gain = p.in[2] + j * D; dst = (bf16*)(ws + WS_WGU) + j * WGU_ELEMS; K = D; N = FF; kind = 1; }
            else if (it < C1) { const int j = (it - C0) / I_FF; li = it - C0 - j * I_FF; W = p.in[5] + (size_t)j * D * FF; gain = p.in[2] + j * D; dst = (bf16*)(ws + WS_WGU) + j * WGU_ELEMS; K = D; N = FF; kind = 2; }
            else if (it < C2) { const int j = (it - C1) / I_FF; li = it - C1 - j * I_FF; W = p.in[6] + (size_t)j * FF * D; dst = (bf16*)(ws + WS_WD) + j * WD_ELEMS; K = FF; N = D; }
            else if (it < C3) { li = it - C2; W = p.in[9]; gain = p.in[7]; dst = (bf16*)(ws + WS_WIN); K = D; N = 4096; }
            else if (it < C4) { li = it - C3; W = p.in[14]; dst = (bf16*)(ws + WS_WOUT); K = 2048; N = D; }
            else if (it < C5) { li = it - C4; W = p.in[16]; gain = p.in[15]; dst = (bf16*)(ws + WS_WDKV); K = D; N = 320; kind = 3; }
            else if (it < C6) { li = it - C5; W = p.in[18]; gain = p.in[17]; dst = (bf16*)(ws + WS_WUKV); K = 256; N = 2048; }
            else if (it < C7) { li = it - C6; W = p.in[19]; gain = p.in[7] + D; dst = (bf16*)(ws + WS_WDQ); K = D; N = 512; }
            else if (it < C8) { li = it - C7; W = p.in[21]; gain = p.in[20]; dst = (bf16*)(ws + WS_WUQ); K = 512; N = 1536; kind = 4; scale = 0.07216878364870322f * 1.4426950408889634f; }
            else              { li = it - C8; W = p.in[22]; dst = (bf16*)(ws + WS_WO); K = D; N = D; }
            transpose_item(W, K, N, gain, scale, dst, kind, scr, li, lane);
        }
    }
    {
        const float* wsrc = p.in[12]; bf16* wm = (bf16*)(ws + WS_WSM);
        for (int i = gw * 64 + lane; i < 16 * 128 * 128 / 4; i += NGW * 64) {
            const f32x4 v = *(const f32x4*)(wsrc + (size_t)i * 4); const int e = i * 4, t = (e >> 7) & 127, c = e & 127;
            v2u o; o.x = pk2(c <= t ? v[0] : 0.f, c + 1 <= t ? v[1] : 0.f); o.y = pk2(c + 2 <= t ? v[2] : 0.f, c + 3 <= t ? v[3] : 0.f);
            *(v2u*)(wm + (size_t)e) = o;
        }
    }
    {
        const int* pos = (const int*)p.in[1]; float* cs = (float*)(ws + WS_COS); float* sn = (float*)(ws + WS_SIN);
        for (int i = gw * 64 + lane; i < T * 32; i += NGW * 64) {
            const int tok = i >> 5, k = i & 31;
            const float inv = __builtin_exp2f(-(float)(2 * k) * (1.f / 64.f) * 13.287712379549449f);
            const float ang = (float)pos[tok] * inv;
            const double a = (double)ang; const double kk = __builtin_rint(a * 0.15915494309189535); const float r = (float)(a - kk * 6.283185307179586);
            cs[i] = __builtin_cosf(r); sn[i] = __builtin_sinf(r);
        }
    }
    row_pass<0>(p.in[0], (bf16*)(ws + WS_HNF), nullptr, nullptr, nullptr, 0.f, (float*)(ws + WS_PART), nullptr, wv);
}

__device__ __forceinline__ s16x4 vtr(const LAS unsigned char* p) { return __builtin_amdgcn_ds_read_tr16_b64_v4i16((LAS s16x4*)p); }
__device__ __forceinline__ bf16x8 tr_frag(const LAS unsigned char* tile, int str, int k0, int n0, int lane) {
    const LAS unsigned char* a = tile + (k0 + 8 * (lane >> 5) + ((lane & 15) >> 2)) * str + (n0 + 16 * ((lane >> 4) & 1) + 4 * (lane & 3)) * 2;
    const s16x4 lo = vtr(a), hi4 = vtr(a + 4 * str);
    return (bf16x8){lo[0], lo[1], lo[2], lo[3], hi4[0], hi4[1], hi4[2], hi4[3]};
}
__device__ __forceinline__ int crow(int r, int hi) { return (r & 3) + 8 * (r >> 2) + 4 * hi; }

constexpr int VNSTR = 320;
__device__ __forceinline__ void gate_ln_store(LAS unsigned char* buf, const LAS float* stats, const v4u (&raw)[4], const float* lng, const float* lnb, int g, int tid) {
#pragma unroll
    for (int i = 0; i < 4; ++i) {
        const int idx = tid + 512 * i, row = idx >> 4, ch = idx & 15;
        const float mean = stats[2 * row], rstd = stats[2 * row + 1];
        const f32x4 g0 = *(const f32x4*)(lng + g * 128 + ch * 8), g1 = *(const f32x4*)(lng + g * 128 + ch * 8 + 4);
        const f32x4 b0 = *(const f32x4*)(lnb + g * 128 + ch * 8), b1 = *(const f32x4*)(lnb + g * 128 + ch * 8 + 4);
        f32x4 x0, x1; x0[0] = bflo(raw[i].x); x0[1] = bfhi(raw[i].x); x0[2] = bflo(raw[i].y); x0[3] = bfhi(raw[i].y); x1[0] = bflo(raw[i].z); x1[1] = bfhi(raw[i].z); x1[2] = bflo(raw[i].w); x1[3] = bfhi(raw[i].w);
        x0 = (x0 - mean) * rstd * g0 + b0; x1 = (x1 - mean) * rstd * g1 + b1;
        *(LAS v4u*)(buf + row * VNSTR + ch * 16) = pg8::pack8(x0, x1);
    }
}
__device__ __forceinline__ void gate_load_v(v4u (&raw)[4], const bf16* V, int tok0, int g, int tid) {
#pragma unroll
    for (int i = 0; i < 4; ++i) { const int idx = tid + 512 * i, row = idx >> 4, ch = idx & 15; raw[i] = __builtin_nontemporal_load((const v4u*)(V + (size_t)(tok0 + row) * 2048 + g * 128 + ch * 8)); }
}
__device__ __forceinline__ void gate_phase(const Params& p, LAS unsigned char* lds, const int wv) {
    int tid_ = (wv << 6) | pg8::fresh_lane(); const int tid = tid_, lane = tid_ & 63, wave = __builtin_amdgcn_readfirstlane(tid_ >> 6);
    unsigned char* ws = p.ws;
    bf16* U = (bf16*)(ws + WS_U); const bf16* V = (const bf16*)(ws + WS_V); const float* vstat = (const float*)(ws + WS_VSTAT);
    const bf16* Wm = (const bf16*)(ws + WS_WSM); const float* lng = p.in[10]; const float* lnb = p.in[11]; const float* bs = p.in[13];
    LAS float* stats = (LAS float*)(lds + 2 * 128 * VNSTR);
    LAS float* wscr = (LAS float*)(lds + 2 * 128 * VNSTR + 1024) + wave * (32 * 33);
    const int r32 = lane & 31, hi = lane >> 5, tq = wave & 3, dh = wave >> 2;
    const int nks = 2 * tq + 2;
    for (int chunk = blockIdx.x; chunk < T / 128; chunk += gridDim.x) {
        const int tok0 = chunk * 128;
        v4u raw[4];
        gate_load_v(raw, V, tok0, 0, tid);
        __syncthreads();
        if (tid < 128) {
            const float* sp = vstat + (size_t)(tok0 + tid) * 64; float s1 = 0.f, s2 = 0.f;
#pragma unroll
            for (int i = 0; i < 16; ++i) { const f32x4 v = *(const f32x4*)(sp + 4 * i); s1 += v[0] + v[2]; s2 += v[1] + v[3]; }
            const float mean = s1 * (1.f / 2048.f), var = s2 * (1.f / 2048.f) - mean * mean;
            stats[2 * tid] = mean; stats[2 * tid + 1] = __builtin_amdgcn_rsqf(var + 1e-5f);
        }
        __syncthreads();
        gate_ln_store(lds, stats, raw, lng, lnb, 0, tid);
        bf16x8 wf[8];
        { const bf16* wrow = Wm + ((size_t)0 * 128 + 32 * tq + r32) * 128 + 8 * hi;
#pragma unroll
          for (int ks = 0; ks < 8; ++ks) if (ks < nks) wf[ks] = *(const bf16x8*)(wrow + 16 * ks); }
        __syncthreads();
        const int tl = lane >> 1, ds0 = (lane & 1) * 16;
        for (int g = 0; g < 16; ++g) {
            const LAS unsigned char* buf = lds + (g & 1) * 128 * VNSTR;
            if (g + 1 < 16) gate_load_v(raw, V, tok0, g + 1, tid);
            bf16* up = U + (size_t)(tok0 + 32 * tq + tl) * 2048 + g * 128 + 64 * dh + ds0;
            const v4u ua0 = *(const v4u*)up, ua1 = *(const v4u*)(up + 8), ub0 = *(const v4u*)(up + 32), ub1 = *(const v4u*)(up + 40);
            float bias[16];
#pragma unroll
            for (int r = 0; r < 16; ++r) bias[r] = bs[g * 128 + 32 * tq + crow(r, hi)];
            f32x16 acc0 = {}, acc1 = {};
#pragma unroll
            for (int ks = 0; ks < 8; ++ks) if (ks < nks) {
                const bf16x8 b0 = tr_frag(buf, VNSTR, 16 * ks, 64 * dh, lane), b1 = tr_frag(buf, VNSTR, 16 * ks, 64 * dh + 32, lane);
                acc0 = __builtin_amdgcn_mfma_f32_32x32x16_bf16(wf[ks], b0, acc0, 0, 0, 0);
                acc1 = __builtin_amdgcn_mfma_f32_32x32x16_bf16(wf[ks], b1, acc1, 0, 0, 0);
            }
            if (g + 1 < 16) {
                const bf16* wrow = Wm + ((size_t)(g + 1) * 128 + 32 * tq + r32) * 128 + 8 * hi;
#pragma unroll
                for (int ks = 0; ks < 8; ++ks) if (ks < nks) wf[ks] = *(const bf16x8*)(wrow + 16 * ks);
                gate_ln_store(lds + ((g + 1) & 1) * 128 * VNSTR, stats, raw, lng, lnb, g + 1, tid);
            }
#pragma unroll
            for (int nb = 0; nb < 2; ++nb) {
#pragma unroll
                for (int r = 0; r < 16; ++r) wscr[crow(r, hi) * 33 + r32] = (nb == 0 ? acc0[r] : acc1[r]) + bias[r];
                asm volatile("s_waitcnt lgkmcnt(0)" ::: "memory");
                const v4u u0 = nb == 0 ? ua0 : ub0, u1 = nb == 0 ? ua1 : ub1;
                const LAS float* sp = wscr + tl * 33 + ds0;
                v4u o0, o1;
                o0.x = pk2(bflo(u0.x) * sp[0], bfhi(u0.x) * sp[1]); o0.y = pk2(bflo(u0.y) * sp[2], bfhi(u0.y) * sp[3]); o0.z = pk2(bflo(u0.z) * sp[4], bfhi(u0.z) * sp[5]); o0.w = pk2(bflo(u0.w) * sp[6], bfhi(u0.w) * sp[7]);
                o1.x = pk2(bflo(u1.x) * sp[8], bfhi(u1.x) * sp[9]); o1.y = pk2(bflo(u1.y) * sp[10], bfhi(u1.y) * sp[11]); o1.z = pk2(bflo(u1.z) * sp[12], bfhi(u1.z) * sp[13]); o1.w = pk2(bflo(u1.w) * sp[14], bfhi(u1.w) * sp[15]);
                *(v4u*)(up + 32 * nb) = o0; *(v4u*)(up + 32 * nb + 8) = o1;
                asm volatile("s_waitcnt lgkmcnt(0)" ::: "memory");
            }
            __syncthreads();
        }
    }
}

constexpr int KNSTR = 272, KRSTR = 144, VSTR = 320, ATT_KR = 64 * KNSTR, ATT_V = ATT_KR + 64 * KRSTR, ATT_BUF = ATT_V + 64 * VSTR;
struct AttStage { v4u k0, k1, k2, v0, v1; };
__device__ __forceinline__ void att_load(AttStage& s, const unsigned char* knb, const unsigned char* krb, const unsigned char* vvb, int tid) {
    const int r0 = tid >> 4, c0 = tid & 15;
    s.k0 = *(const v4u*)(knb + (size_t)r0 * 2048 + c0 * 16); s.k1 = *(const v4u*)(knb + (size_t)(32 + r0) * 2048 + c0 * 16);
    s.k2 = *(const v4u*)(krb + (size_t)(tid >> 3) * 128 + (tid & 7) * 16);
    s.v0 = *(const v4u*)(vvb + (size_t)r0 * 2048 + c0 * 16); s.v1 = *(const v4u*)(vvb + (size_t)(32 + r0) * 2048 + c0 * 16);
}
__device__ __forceinline__ void att_store(const AttStage& s, LAS unsigned char* buf, int tid) {
    const int r0 = tid >> 4, c0 = tid & 15;
    *(LAS v4u*)(buf + r0 * KNSTR + c0 * 16) = s.k0; *(LAS v4u*)(buf + (32 + r0) * KNSTR + c0 * 16) = s.k1;
    *(LAS v4u*)(buf + ATT_KR + (tid >> 3) * KRSTR + (tid & 7) * 16) = s.k2;
    *(LAS v4u*)(buf + ATT_V + r0 * VSTR + c0 * 16) = s.v0; *(LAS v4u*)(buf + ATT_V + (32 + r0) * VSTR + c0 * 16) = s.v1;
}
#define ATT_SB() __builtin_amdgcn_sched_barrier(0)
__device__ __forceinline__ void att_unit(LAS unsigned char* lds, const bf16* Q, const bf16* KN, const bf16* KR, const bf16* VV, bf16* O, int b, int h, int qb, int tid, int wave, int lane) {
    const int r32 = lane & 31, hi = lane >> 5;
    const int q0 = qb * 256, tok0 = b * SEQ, NT = 4 * qb + 4;
    const int qw0 = q0 + 32 * wave, qpos = qw0 + r32;
    const int prow = (r32 & 19) | ((r32 & 4) << 1) | ((r32 & 8) >> 1);
    const unsigned char* knb = (const unsigned char*)(KN + (size_t)tok0 * 1024 + h * 128);
    const unsigned char* krb = (const unsigned char*)(KR + (size_t)tok0 * 64);
    const unsigned char* vvb = (const unsigned char*)(VV + (size_t)tok0 * 1024 + h * 128);
    bf16x8 qf[12];
    { const bf16* qp = Q + (size_t)(tok0 + qpos) * 1536 + h * 192 + hi * 8;
#pragma unroll
      for (int d0 = 0; d0 < 12; ++d0) qf[d0] = *(const bf16x8*)(qp + d0 * 16); }
    f32x16 o0 = {}, o1 = {}, o2 = {}, o3 = {};
    float mrun = -1e30f, lrun = 0.f;
    AttStage st;
    att_load(st, knb, krb, vvb, tid);
    __syncthreads();
    att_store(st, lds, tid);
    __syncthreads();
    const int koff = prow * KNSTR + hi * 16, roff = ATT_KR + prow * KRSTR + hi * 16;
    const int voff = ATT_V + (8 * hi + ((lane & 15) >> 2)) * VSTR + (16 * ((lane >> 4) & 1) + 4 * (lane & 3)) * 2;
    for (int t = 0; t < NT; ++t) {
        const int cur = t & 1;
        const LAS unsigned char* bufc = lds + cur * ATT_BUF;
        if (t + 1 < NT) att_load(st, knb + (size_t)(t + 1) * 64 * 2048, krb + (size_t)(t + 1) * 64 * 128, vvb + (size_t)(t + 1) * 64 * 2048, tid);
        const int kv0 = 64 * t;
#pragma unroll
        for (int kb = 0; kb < 2; ++kb) {
            const int kvb = kv0 + 32 * kb;
            if (kvb <= qw0 + 31) {
                const LAS unsigned char* kp = bufc + kb * 32 * KNSTR + koff;
                const LAS unsigned char* rp = bufc + kb * 32 * KRSTR + roff;
                const LAS unsigned char* vp = bufc + kb * 32 * VSTR + voff;
                bf16x8 ka[4], kc[2];
#pragma unroll
                for (int i = 0; i < 4; ++i) ka[i] = *(const LAS bf16x8*)(kp + i * 32);
#pragma unroll
                for (int i = 0; i < 2; ++i) kc[i] = *(const LAS bf16x8*)(kp + 128 + i * 32);
                ATT_SB();
                f32x16 s = {};
                __builtin_amdgcn_s_setprio(1);
#pragma unroll
                for (int i = 0; i < 4; ++i) s = __builtin_amdgcn_mfma_f32_32x32x16_bf16(ka[i], qf[i], s, 0, 0, 0);
#pragma unroll
                for (int i = 0; i < 2; ++i) ka[i] = *(const LAS bf16x8*)(kp + 192 + i * 32);
#pragma unroll
                for (int i = 0; i < 2; ++i) ka[2 + i] = *(const LAS bf16x8*)(rp + i * 32);
                ATT_SB();
#pragma unroll
                for (int i = 0; i < 2; ++i) s = __builtin_amdgcn_mfma_f32_32x32x16_bf16(kc[i], qf[4 + i], s, 0, 0, 0);
#pragma unroll
                for (int i = 0; i < 2; ++i) kc[i] = *(const LAS bf16x8*)(rp + 64 + i * 32);
                ATT_SB();
#pragma unroll
                for (int i = 0; i < 2; ++i) s = __builtin_amdgcn_mfma_f32_32x32x16_bf16(ka[i], qf[6 + i], s, 0, 0, 0);
#pragma unroll
                for (int i = 0; i < 2; ++i) s = __builtin_amdgcn_mfma_f32_32x32x16_bf16(ka[2 + i], qf[8 + i], s, 0, 0, 0);
                ATT_SB();
#pragma unroll
                for (int i = 0; i < 2; ++i) s = __builtin_amdgcn_mfma_f32_32x32x16_bf16(kc[i], qf[10 + i], s, 0, 0, 0);
                __builtin_amdgcn_s_setprio(0);
                s16x4 va[8], vb[8];
                ATT_SB();
                if (kvb + 31 > qw0) {
                    asm volatile("");
#pragma unroll
                    for (int r = 0; r < 16; ++r) { const int kv = kvb + 16 * (r >> 3) + 8 * hi + (r & 7); if (kv > qpos) s[r] = -1e30f; }
                }
                float mx = fmaxf(fmaxf(s[0], s[1]), fmaxf(s[2], s[3]));
#pragma unroll
                for (int r = 4; r < 16; r += 4) mx = fmaxf(mx, fmaxf(fmaxf(s[r], s[r + 1]), fmaxf(s[r + 2], s[r + 3])));
                { const auto rr = __builtin_amdgcn_permlane32_swap(__float_as_uint(mx), __float_as_uint(mx), false, false); mx = fmaxf(__uint_as_float(rr[0]), __uint_as_float(rr[1])); }
                if (__any(mx > mrun + 8.f)) {
                    const float mnew = fmaxf(mrun, mx), alpha = __builtin_amdgcn_exp2f(mrun - mnew);
                    mrun = mnew; lrun *= alpha; o0 *= alpha; o1 *= alpha; o2 *= alpha; o3 *= alpha;
                }
                float ls = 0.f;
#pragma unroll
                for (int r = 0; r < 16; ++r) { s[r] = __builtin_amdgcn_exp2f(s[r] - mrun); ls += s[r]; }
                lrun += ls;
                v4u pa, pb;
                pa.x = pk2(s[0], s[1]); pa.y = pk2(s[2], s[3]); pa.z = pk2(s[4], s[5]); pa.w = pk2(s[6], s[7]);
                pb.x = pk2(s[8], s[9]); pb.y = pk2(s[10], s[11]); pb.z = pk2(s[12], s[13]); pb.w = pk2(s[14], s[15]);
                const bf16x8 p0 = __builtin_bit_cast(bf16x8, pa), p1 = __builtin_bit_cast(bf16x8, pb);
#pragma unroll
                for (int d = 0; d < 4; ++d) { va[2 * d] = vtr(vp + d * 64); va[2 * d + 1] = vtr(vp + d * 64 + 4 * VSTR); }
#pragma unroll
                for (int d = 0; d < 4; ++d) { vb[2 * d] = vtr(vp + 16 * VSTR + d * 64); vb[2 * d + 1] = vtr(vp + 20 * VSTR + d * 64); }
#define VF(x, d) (bf16x8){x[2 * d][0], x[2 * d][1], x[2 * d][2], x[2 * d][3], x[2 * d + 1][0], x[2 * d + 1][1], x[2 * d + 1][2], x[2 * d + 1][3]}
                __builtin_amdgcn_s_setprio(1);
                o0 = __builtin_amdgcn_mfma_f32_32x32x16_bf16(VF(va, 0), p0, o0, 0, 0, 0);
                o1 = __builtin_amdgcn_mfma_f32_32x32x16_bf16(VF(va, 1), p0, o1, 0, 0, 0);
                o2 = __builtin_amdgcn_mfma_f32_32x32x16_bf16(VF(va, 2), p0, o2, 0, 0, 0);
                o3 = __builtin_amdgcn_mfma_f32_32x32x16_bf16(VF(va, 3), p0, o3, 0, 0, 0);
                o0 = __builtin_amdgcn_mfma_f32_32x32x16_bf16(VF(vb, 0), p1, o0, 0, 0, 0);
                o1 = __builtin_amdgcn_mfma_f32_32x32x16_bf16(VF(vb, 1), p1, o1, 0, 0, 0);
                o2 = __builtin_amdgcn_mfma_f32_32x32x16_bf16(VF(vb, 2), p1, o2, 0, 0, 0);
                o3 = __builtin_amdgcn_mfma_f32_32x32x16_bf16(VF(vb, 3), p1, o3, 0, 0, 0);
                __builtin_amdgcn_s_setprio(0);
#undef VF
                ATT_SB();
            }
        }
        if (t + 1 < NT) att_store(st, lds + (cur ^ 1) * ATT_BUF, tid);
        __syncthreads();
    }
    lrun += __shfl_xor(lrun, 32);
    const float inv = 1.f / lrun;
    bf16* op = O + (size_t)(tok0 + qpos) * 1024 + h * 128 + 4 * hi;
#pragma unroll
    for (int g4 = 0; g4 < 4; ++g4) {
        v2u w;
        w.x = pk2(o0[4 * g4] * inv, o0[4 * g4 + 1] * inv); w.y = pk2(o0[4 * g4 + 2] * inv, o0[4 * g4 + 3] * inv); *(v2u*)(op + 0 + 8 * g4) = w;
        w.x = pk2(o1[4 * g4] * inv, o1[4 * g4 + 1] * inv); w.y = pk2(o1[4 * g4 + 2] * inv, o1[4 * g4 + 3] * inv); *(v2u*)(op + 32 + 8 * g4) = w;
        w.x = pk2(o2[4 * g4] * inv, o2[4 * g4 + 1] * inv); w.y = pk2(o2[4 * g4 + 2] * inv, o2[4 * g4 + 3] * inv); *(v2u*)(op + 64 + 8 * g4) = w;
        w.x = pk2(o3[4 * g4] * inv, o3[4 * g4 + 1] * inv); w.y = pk2(o3[4 * g4 + 2] * inv, o3[4 * g4 + 3] * inv); *(v2u*)(op + 96 + 8 * g4) = w;
    }
}
__device__ __forceinline__ void att_phase(const Params& p, LAS unsigned char* lds, const int wv) {
    int tid_ = (wv << 6) | pg8::fresh_lane(); const int tid = tid_, lane = tid_ & 63, wave = __builtin_amdgcn_readfirstlane(tid_ >> 6);
    unsigned char* ws = p.ws;
    const bf16* Q = (const bf16*)(ws + WS_Q); const bf16* KN = (const bf16*)(ws + WS_KN); const bf16* KR = (const bf16*)(ws + WS_KR); const bf16* VV = (const bf16*)(ws + WS_VV); bf16* O = (bf16*)(ws + WS_O);
    for (int pi = blockIdx.x; pi < NB * 8 * 4; pi += gridDim.x) {
        const int x = pi & 7, lp = ((pi >> 3) & 31) + 32 * (pi >> 8);
        const int pair = (gridDim.x == 256) ? (x * 64 + lp) : pi;
        const int bh = pair >> 2, s = pair & 3, b = bh >> 3, h = bh & 7;
        att_unit(lds, Q, KN, KR, VV, O, b, h, 7 - s, tid, wave, lane);
        att_unit(lds, Q, KN, KR, VV, O, b, h, s, tid, wave, lane);
    }
}

#define XB_TMO      128
#define XB_XCNT(j)  (256  + 64 * (j))
#define XB_XSUB(j)  (1280 + 64 * (j))
#define XB_XGEN(j)  (2304 + 64 * (j))
#define XB_TOP      3328
#define XB_TOPGEN   3392
#define XCD_BAR_WORDS 3456
#define XB_SPIN_CAP (1u << 18)

__device__ __forceinline__ unsigned xb_ld(unsigned* p)              { return __hip_atomic_load(p, __ATOMIC_RELAXED, __HIP_MEMORY_SCOPE_AGENT); }
__device__ __forceinline__ unsigned xb_add(unsigned* p, unsigned v) { return __hip_atomic_fetch_add(p, v, __ATOMIC_RELAXED, __HIP_MEMORY_SCOPE_AGENT); }
__device__ __forceinline__ unsigned xb_xcc_id() { return (unsigned)__builtin_amdgcn_s_getreg((3 << 11) | 20) & 0xFu; }
#define XB_SPIN(cond, bar) do { unsigned _sp = 0; while (cond) { __builtin_amdgcn_s_sleep(1); \
    if ((++_sp & 255u) == 0u) { if (xb_ld(&(bar)[XB_TMO])) break; if (_sp > XB_SPIN_CAP) { atomicAdd(&(bar)[XB_TMO], 1u); break; } } } } while (0)

struct XcdBarrier {
    int wv;
    unsigned* bar; unsigned x;
    volatile LAS unsigned* st;
};

__device__ __forceinline__ XcdBarrier xcd_barrier_post(unsigned* bar, volatile LAS unsigned* st, int wv) {
    XcdBarrier b; b.bar = bar; b.x = xb_xcc_id(); b.st = st; b.wv = wv;
    if (wv == 0 && pg8::fresh_lane() == 0) (void)xb_add(&bar[XB_XCNT(b.x)], 1u);
    return b;
}
__device__ __forceinline__ void xcd_barrier_complete(unsigned* bar, unsigned x, unsigned& nloc, unsigned& nx) {
    const unsigned G = gridDim.x * gridDim.y * gridDim.z;
    unsigned sum, cnt, mine, sp = 0u;
    for (;;) {
        sum = 0u; cnt = 0u; mine = 0u;
#pragma unroll
        for (unsigned j = 0; j < 16; ++j) { const unsigned c = xb_ld(&bar[XB_XCNT(j)]); sum += c; cnt += (c > 0u) ? 1u : 0u; mine = (j == x) ? c : mine; }
        if (sum == G) break;
        __builtin_amdgcn_s_sleep(1);
        if ((++sp & 255u) == 0u) { if (xb_ld(&bar[XB_TMO])) break; if (sp > XB_SPIN_CAP) { atomicAdd(&bar[XB_TMO], 1u); break; } }
    }
    nloc = mine > 0u ? mine : 1u; nx = cnt > 0u ? cnt : 1u;
}

__device__ __forceinline__ void xcd_barrier(const XcdBarrier& b) {
    asm volatile("s_waitcnt vmcnt(0)" ::: "memory");
    __syncthreads();
    if (b.wv == 0 && pg8::fresh_lane() == 0) {
        unsigned* bar = b.bar;
        __builtin_amdgcn_s_waitcnt(0);
        unsigned nloc = b.st[0], nx = b.st[1];
        if (nloc == 0u) { xcd_barrier_complete(bar, b.x, nloc, nx); b.st[0] = nloc; b.st[1] = nx; }
        const unsigned old = xb_add(&bar[XB_XSUB(b.x)], 1u);
        const unsigned gen = old / nloc;
        if (old + 1u == (gen + 1u) * nloc) {
            __builtin_amdgcn_fence(__ATOMIC_RELEASE, "agent");
            asm volatile("s_waitcnt vmcnt(0)" ::: "memory");
            const unsigned og = xb_add(&bar[XB_TOP], 1u);
            const unsigned tg = og / nx;
            if (og + 1u == (tg + 1u) * nx) xb_add(&bar[XB_TOPGEN], 1u);
            else XB_SPIN(xb_ld(&bar[XB_TOPGEN]) == tg, bar);
            __builtin_amdgcn_fence(__ATOMIC_ACQUIRE, "agent");
            xb_add(&bar[XB_XGEN(b.x)], 1u);
            asm volatile("s_waitcnt vmcnt(0)" ::: "memory");
        } else {
            XB_SPIN(xb_ld(&bar[XB_XGEN(b.x)]) == gen, bar);
            __builtin_amdgcn_fence(__ATOMIC_ACQUIRE, "agent");
            asm volatile("s_waitcnt vmcnt(0)" ::: "memory");
        }
    }
    __syncthreads();
}

template <class Epi>
__device__ __forceinline__ void run_gemm(LAS unsigned char* lds, const bf16* A, const bf16* Bt, int N, int K, const Epi& E, const int wv) {
    pg8::Gemm g{A, Bt, T, N, K}; pg8::StaticOrder S; S.init(T, N, (int)gridDim.x, (int)blockIdx.x);
    pg8::gemm_phase<Epi, pg8::StaticOrder, true, true>(lds, g, S, E, wv);
}

__global__ void __launch_bounds__(NTHREADS, 2) yoco_fwd(Params p) {
    extern __shared__ __attribute__((aligned(16))) unsigned char lds_raw[];
    LAS unsigned char* lds = (LAS unsigned char*)lds_raw;
    cg::grid_group grid = cg::this_grid();
    volatile LAS unsigned* bst = (volatile LAS unsigned*)(lds + LDS_BYTES - 16);
    const int WV = __builtin_amdgcn_readfirstlane((int)threadIdx.x >> 6);
    if (WV == 0 && pg8::fresh_lane() < 4) bst[pg8::fresh_lane()] = 0u;
    if (blockIdx.x == 0) { unsigned* cw = (unsigned*)(p.ws + WS_BAR); for (int i = (WV << 6) | pg8::fresh_lane(); i < 16384 / 4; i += NTHREADS) cw[i] = 0u; }
    { unsigned* xb = (unsigned*)(p.ws + WS_XBUF); for (int i = blockIdx.x * NTHREADS + ((WV << 6) | pg8::fresh_lane()); i < T * 4; i += gridDim.x * NTHREADS) xb[i] = 0u; }
    asm volatile("s_waitcnt vmcnt(0)" ::: "memory");
    grid.sync();
    const XcdBarrier bar = xcd_barrier_post((unsigned*)(p.ws + WS_BAR), bst, WV);
#define GRID_SYNC() xcd_barrier(bar)
    unsigned char* ws = p.ws;
    bf16* HNF = (bf16*)(ws + WS_HNF); bf16* HID = (bf16*)(ws + WS_HID); float* PART = (float*)(ws + WS_PART);
    const float* cs = (const float*)(ws + WS_COS); const float* sn = (const float*)(ws + WS_SIN);

    prologue(p, lds, WV);
    GRID_SYNC();

#define PSS(k) pg8::PanelSS{(unsigned*)(ws + WS_XBUF), (unsigned)(k)}
#define FFN_BLOCK(lj, LAST, k) do { \
        run_gemm(lds, HNF, (const bf16*)(ws + WS_WGU) + (size_t)(lj) * WGU_ELEMS, 2 * FF, D, pg8::EpiSwiGLU{HID, FF, PART}, WV); \
        GRID_SYNC(); \
        run_gemm(lds, HID, (const bf16*)(ws + WS_WD) + (size_t)(lj) * WD_ELEMS, D, FF, pg8::EpiRes<LAST>{HNF, p.in[3] + (lj) * D, 0.5f, PART, p.out, PSS(k), lds + 131072}, WV); \
        if (!(LAST)) GRID_SYNC(); \
    } while (0)

    FFN_BLOCK(0, false, 1);
    run_gemm(lds, HNF, (const bf16*)(ws + WS_WIN), 4096, D, pg8::EpiGelu{(bf16*)(ws + WS_U), (bf16*)(ws + WS_V), (float*)(ws + WS_VSTAT), PART}, WV);
    GRID_SYNC();
    gate_phase(p, lds, WV);
    GRID_SYNC();
    run_gemm(lds, (const bf16*)(ws + WS_U), (const bf16*)(ws + WS_WOUT), D, 2048, pg8::EpiRes<false>{HNF, p.in[8], 1.0f, PART, p.out, PSS(2), lds + 131072}, WV);
    GRID_SYNC();
    FFN_BLOCK(1, false, 3);
    run_gemm(lds, HNF, (const bf16*)(ws + WS_WDKV), 512, D, pg8::EpiDkv{(bf16*)(ws + WS_C), (float*)(ws + WS_CPART), (bf16*)(ws + WS_KR), cs, sn, PART}, WV);
    GRID_SYNC();
    run_gemm(lds, (const bf16*)(ws + WS_C), (const bf16*)(ws + WS_WUKV), 2048, 256, pg8::EpiUkv{(bf16*)(ws + WS_KN), (bf16*)(ws + WS_VV), (const float*)(ws + WS_CPART)}, WV);
    FFN_BLOCK(2, false, 4);
    run_gemm(lds, HNF, (const bf16*)(ws + WS_WDQ), 512, D, pg8::EpiStat{(bf16*)(ws + WS_QC), 512, (float*)(ws + WS_QPART), 8, PART}, WV);
    GRID_SYNC();
    run_gemm(lds, (const bf16*)(ws + WS_QC), (const bf16*)(ws + WS_WUQ), 1536, 512, pg8::EpiUq{(bf16*)(ws + WS_Q), (const float*)(ws + WS_QPART), cs, sn}, WV);
    GRID_SYNC();
    att_phase(p, lds, WV);
    GRID_SYNC();
    run_gemm(lds, (const bf16*)(ws + WS_O), (const bf16*)(ws + WS_WO), D, D, pg8::EpiRes<false>{HNF, p.in[8] + D, 1.0f, PART, p.out, PSS(5), lds + 131072}, WV);
    GRID_SYNC();
    FFN_BLOCK(3, true, 6);
#undef PSS
#undef FFN_BLOCK
}

extern "C" void kernel_launch(void* const* d_in, const int* in_sizes, int n_in, void* d_out, int out_size, void* d_ws, size_t ws_size, hipStream_t stream) {
    static int grid = 0;
    if (grid == 0) {
        if (n_in != 23 || out_size != T * D || ws_size < WS_END) { fprintf(stderr, "kernel_launch: unexpected sizes n_in %d out %d ws %zu\n", n_in, out_size, ws_size); grid = -1; return; }
        int dev = 0, cus = 0, per_cu = 0;
        hipGetDevice(&dev);
        hipDeviceGetAttribute(&cus, hipDeviceAttributeMultiprocessorCount, dev);
        hipFuncSetAttribute((const void*)yoco_fwd, hipFuncAttributeMaxDynamicSharedMemorySize, LDS_BYTES);
        hipOccupancyMaxActiveBlocksPerMultiprocessor(&per_cu, (const void*)yoco_fwd, NTHREADS, LDS_BYTES);
        if (per_cu < 1) per_cu = 1;
        grid = cus * per_cu;
        if (grid > 256) grid = 256;
        (void)hipGetLastError();
    }
    if (grid < 0) return;
    Params p{};
    for (int i = 0; i < 23; ++i) p.in[i] = (const float*)d_in[i];
    p.out = (float*)d_out; p.ws = (unsigned char*)d_ws;
    void* args[] = {&p};
    hipError_t e = hipLaunchCooperativeKernel((const void*)yoco_fwd, dim3(grid), dim3(NTHREADS), args, LDS_BYTES, stream);
    if (e != hipSuccess) fprintf(stderr, "cooperative launch failed: %s (grid %d)\n", hipGetErrorString(e), grid);
}
```

```cpp
#include <hip/hip_runtime.h>
#include <hip/hip_cooperative_groups.h>
#include <cstdio>
#include <cstdint>
namespace cg = cooperative_groups;
namespace pg8 {
#define PG8_LAS __attribute__((address_space(3)))
typedef unsigned short bf16_t;
__device__ __forceinline__ int fresh_lane() { int l; asm volatile("v_mbcnt_lo_u32_b32 %0, -1, 0\n\tv_mbcnt_hi_u32_b32 %0, -1, %0" : "=v"(l)); return l; }
typedef short bf16x8 __attribute__((ext_vector_type(8)));
typedef float f32x4 __attribute__((ext_vector_type(4)));
typedef unsigned u32x4 __attribute__((ext_vector_type(4)));
constexpr int BM = 256, BK = 64, HALF = 128, HTB = HALF * BK * 2  , STAGE_BYTES = 8 * HTB, NXCD = 8, WGM = 4;

__host__ __device__ __forceinline__ int lds_byte(int r, int c) { const int st = (r >> 4) * 2 + (c >> 5), rr = r & 15, cc = c & 31, ob = rr * 64 + cc * 2; return st * 1024 + (ob ^ (((ob >> 9) & 1) << 5)); }
__host__ __device__ __forceinline__ void stage_rc(int b, int& R, int& C) { const int st = b / 1024, sb = b % 1024, swz = sb ^ (((sb >> 9) & 1) << 5); R = (st >> 1) * 16 + swz / 64; C = (st & 1) * 32 + (swz % 64) / 2; }
__host__ __device__ __forceinline__ int perm32(int rho) { const int n = rho >> 4, i = rho & 15; return 8 * (i >> 2) + 4 * n + (i & 3); }

struct Unit { int pm, pn; };
struct Gemm { const bf16_t* A; const bf16_t* Bt; int M, N, K; };

struct StaticOrder {
    int nM, nN, nwg, G, c;
    __host__ __device__ void init(int M, int N, int G_, int c_) { nM = M / BM; nN = N / BM; nwg = nM * nN; G = G_; c = c_; }
    __host__ __device__ bool next(int i, Unit& u) const {
        const long L = (long)i * G + c; if (L >= nwg) return false;
        int wgid = (int)L; { const int q = nwg / NXCD, r = nwg % NXCD, xcd = wgid % NXCD, off = wgid / NXCD; wgid = (xcd < r ? xcd * (q + 1) : r * (q + 1) + (xcd - r) * q) + off; }
        const int nig = WGM * nN, gid = wgid / nig, fm = gid * WGM, gsz = (nM - fm) < WGM ? (nM - fm) : WGM;
        u.pm = fm + ((wgid % nig) % gsz); u.pn = (wgid % nig) / gsz; return true;
    }
    __device__ __forceinline__ void a_ready(const Unit&) const {}
    __device__ __forceinline__ void done(const Unit&) const {}
};

__device__ __forceinline__ unsigned cvt_pk_bf16(float lo, float hi) { unsigned r; asm volatile("v_cvt_pk_bf16_f32 %0, %1, %2" : "=v"(r) : "v"(lo), "v"(hi)); return r; }
typedef float f32x2 __attribute__((ext_vector_type(2)));
__device__ __forceinline__ float silu_f(float x) { return x * __builtin_amdgcn_rcpf(1.f + __builtin_amdgcn_exp2f(-1.4426950408889634f * x)); }
__device__ __forceinline__ float gelu_f(float x) { const float t = x * (1.f + 0.044715f * x * x); return x * __builtin_amdgcn_rcpf(1.f + __builtin_amdgcn_exp2f(-2.302208198f * t)); }
__device__ __forceinline__ u32x4 pack8(const f32x4 a, const f32x4 b) { u32x4 w; w.x = cvt_pk_bf16(a[0], a[1]); w.y = cvt_pk_bf16(a[2], a[3]); w.z = cvt_pk_bf16(b[0], b[1]); w.w = cvt_pk_bf16(b[2], b[3]); return w; }
__device__ __forceinline__ float dot4(const f32x4 a) { return (a[0] * a[0] + a[1] * a[1]) + (a[2] * a[2] + a[3] * a[3]); }
__device__ __forceinline__ float sum4(const f32x4 a) { return (a[0] + a[1]) + (a[2] + a[3]); }
__device__ __forceinline__ void rows_rstd(float (&rr)[2][4], const float* part, int row0, int fq) {
    f32x4 v[2][4];
#pragma unroll
    for (int ai = 0; ai < 2; ++ai)
#pragma unroll
        for (int m = 0; m < 4; ++m) v[ai][m] = *(const f32x4*)(part + (size_t)(row0 + ai * HALF + m * 16) * 16 + 4 * fq);
#pragma unroll
    for (int ai = 0; ai < 2; ++ai)
#pragma unroll
        for (int m = 0; m < 4; ++m) { float s = sum4(v[ai][m]); s += __shfl_xor(s, 16); s += __shfl_xor(s, 32); rr[ai][m] = __builtin_amdgcn_rsqf(s * (1.f / 1024.f) + 1e-6f); }
}

struct EpiSwiGLU {
    static constexpr bool PERM = true, AFTER_DRAIN = false;
    bf16_t* O; int ldc; const float* rs;
    __device__ __forceinline__ void operator()(const f32x4 (&acc)[2][2][4][2], const Unit& u, int wr, int wc, int fr, int fq) const {
        const int row0 = u.pm * BM + wr * 64 + fr, col0 = u.pn * 128 + wc * 32 + 8 * fq;
        float rr[2][4]; rows_rstd(rr, rs, row0, fq);
#pragma unroll
        for (int ai = 0; ai < 2; ++ai)
#pragma unroll
            for (int m = 0; m < 4; ++m) {
                const float r = rr[ai][m], rl = -1.4426950408889634f * r, r2 = r * r;
                const f32x4 g0 = acc[ai][0][m][0], g1 = acc[ai][0][m][1];
                f32x4 e0 = g0 * rl, e1 = g1 * rl;
#pragma unroll
                for (int i = 0; i < 4; ++i) { e0[i] = __builtin_amdgcn_exp2f(e0[i]); e1[i] = __builtin_amdgcn_exp2f(e1[i]); }
                e0 = e0 + 1.0f; e1 = e1 + 1.0f;
#pragma unroll
                for (int i = 0; i < 4; ++i) { e0[i] = __builtin_amdgcn_rcpf(e0[i]); e1[i] = __builtin_amdgcn_rcpf(e1[i]); }
                const f32x4 h0 = (g0 * acc[ai][1][m][0]) * (e0 * r2), h1 = (g1 * acc[ai][1][m][1]) * (e1 * r2);
                *(u32x4*)(O + (size_t)(row0 + ai * HALF + m * 16) * ldc + col0) = pack8(h0, h1);
            }
    }
};
struct EpiStat {
    static constexpr bool PERM = true, AFTER_DRAIN = false;
    bf16_t* O; int ldc; float* part; int np; const float* rs;
    __device__ __forceinline__ void operator()(const f32x4 (&acc)[2][2][4][2], const Unit& u, int wr, int wc, int fr, int fq) const {
        const int row0 = u.pm * BM + wr * 64 + fr, col0 = u.pn * BM + wc * 32 + 8 * fq;
        float rr[2][4];
        if (rs) rows_rstd(rr, rs, row0, fq);
#pragma unroll
        for (int ai = 0; ai < 2; ++ai)
#pragma unroll
            for (int m = 0; m < 4; ++m) {
                const int row = row0 + ai * HALF + m * 16; float s = 0.f; const float r = rs ? rr[ai][m] : 1.f;
#pragma unroll
                for (int bj = 0; bj < 2; ++bj) { const f32x4 v0 = acc[ai][bj][m][0] * r, v1 = acc[ai][bj][m][1] * r; s += dot4(v0) + dot4(v1);
                    *(u32x4*)(O + (size_t)row * ldc + col0 + bj * HALF) = pack8(v0, v1); }
                s += __shfl_xor(s, 16); s += __shfl_xor(s, 32);
                if (fq == 0) part[(size_t)row * np + u.pn * 4 + wc] = s;
            }
    }
};
struct EpiGelu {
    static constexpr bool PERM = true, AFTER_DRAIN = false;
    bf16_t* U; bf16_t* V; float* vstat; const float* rs;
    __device__ __forceinline__ void operator()(const f32x4 (&acc)[2][2][4][2], const Unit& u, int wr, int wc, int fr, int fq) const {
        const bool isv = u.pn >= 8; const int pnl = u.pn & 7; bf16_t* base = isv ? V : U;
        const int row0 = u.pm * BM + wr * 64 + fr, col0 = pnl * BM + wc * 32 + 8 * fq;
        float rr[2][4]; rows_rstd(rr, rs, row0, fq);
#pragma unroll
        for (int ai = 0; ai < 2; ++ai)
#pragma unroll
            for (int m = 0; m < 4; ++m) {
                const int row = row0 + ai * HALF + m * 16; float s1 = 0.f, s2 = 0.f; const float r = rr[ai][m];
#pragma unroll
                for (int bj = 0; bj < 2; ++bj) {
                    const f32x4 x0 = acc[ai][bj][m][0] * r, x1 = acc[ai][bj][m][1] * r;
                    f32x4 e0 = (x0 * x0 * 0.044715f + 1.0f) * (x0 * -2.302208198f), e1 = (x1 * x1 * 0.044715f + 1.0f) * (x1 * -2.302208198f);
#pragma unroll
                    for (int i = 0; i < 4; ++i) { e0[i] = __builtin_amdgcn_exp2f(e0[i]); e1[i] = __builtin_amdgcn_exp2f(e1[i]); }
                    e0 = e0 + 1.0f; e1 = e1 + 1.0f;
#pragma unroll
                    for (int i = 0; i < 4; ++i) { e0[i] = __builtin_amdgcn_rcpf(e0[i]); e1[i] = __builtin_amdgcn_rcpf(e1[i]); }
                    const f32x4 v0 = x0 * e0, v1 = x1 * e1;
                    s1 += sum4(v0) + sum4(v1); s2 += dot4(v0) + dot4(v1);
                    *(u32x4*)(base + (size_t)row * 2048 + col0 + bj * HALF) = pack8(v0, v1); }
                if (isv) { s1 += __shfl_xor(s1, 16); s1 += __shfl_xor(s1, 32); s2 += __shfl_xor(s2, 16); s2 += __shfl_xor(s2, 32);
                    if (fq == 0) { f32x2 st; st.x = s1; st.y = s2; *(f32x2*)(vstat + ((size_t)row * 32 + pnl * 4 + wc) * 2) = st; } }
            }
    }
};
struct EpiDkv {
    static constexpr bool PERM = true, AFTER_DRAIN = false;
    bf16_t* C; float* cpart; bf16_t* KR; const float* cs; const float* sn; const float* rs;
    __device__ __forceinline__ void operator()(const f32x4 (&acc)[2][2][4][2], const Unit& u, int wr, int wc, int fr, int fq) const {
        const int row0 = u.pm * BM + wr * 64 + fr;
        float rr[2][4]; rows_rstd(rr, rs, row0, fq);
        if (u.pn == 0) {
            const int col0 = wc * 32 + 8 * fq;
#pragma unroll
            for (int ai = 0; ai < 2; ++ai)
#pragma unroll
                for (int m = 0; m < 4; ++m) {
                    const int row = row0 + ai * HALF + m * 16; float s = 0.f; const float r = rr[ai][m];
#pragma unroll
                    for (int bj = 0; bj < 2; ++bj) { const f32x4 v0 = acc[ai][bj][m][0] * r, v1 = acc[ai][bj][m][1] * r; s += dot4(v0) + dot4(v1);
                        *(u32x4*)(C + (size_t)row * 256 + col0 + bj * HALF) = pack8(v0, v1); }
                    s += __shfl_xor(s, 16); s += __shfl_xor(s, 32);
                    if (fq == 0) cpart[(size_t)row * 4 + wc] = s;
                }
        } else if (wc == 0) {
#pragma unroll
            for (int ai = 0; ai < 2; ++ai)
#pragma unroll
                for (int m = 0; m < 4; ++m) {
                    const int row = row0 + ai * HALF + m * 16;
                    const f32x4 c0 = *(const f32x4*)(cs + (size_t)row * 32 + 8 * fq), c1 = *(const f32x4*)(cs + (size_t)row * 32 + 8 * fq + 4);
                    const f32x4 s0 = *(const f32x4*)(sn + (size_t)row * 32 + 8 * fq), s1 = *(const f32x4*)(sn + (size_t)row * 32 + 8 * fq + 4);
                    const float r = rr[ai][m];
                    const f32x4 a0 = acc[ai][0][m][0] * r, a1 = acc[ai][0][m][1] * r, b0 = acc[ai][1][m][0] * r, b1 = acc[ai][1][m][1] * r;
                    *(u32x4*)(KR + (size_t)row * 64 + 8 * fq) = pack8(a0 * c0 - b0 * s0, a1 * c1 - b1 * s1);
                    *(u32x4*)(KR + (size_t)row * 64 + 32 + 8 * fq) = pack8(b0 * c0 + a0 * s0, b1 * c1 + a1 * s1);
                    asm volatile("" ::: "memory");
                }
        }
    }
};
struct PanelSS {
    unsigned* xbuf; unsigned tag;
    __device__ __forceinline__ void run(const f32x4 (&v)[2][2][4][2], const Unit& u, int wr, int wc, int fr, int fq, PG8_LAS unsigned char* tab) const {
        PG8_LAS float* P = (PG8_LAS float*)tab; PG8_LAS float* S = (PG8_LAS float*)(tab + 4096);
        const int wid = wr * 4 + wc, lane = fq * 16 + fr;
#pragma unroll
        for (int ai = 0; ai < 2; ++ai)
#pragma unroll
            for (int m = 0; m < 4; ++m) { float s = 0.f;
#pragma unroll
                for (int bj = 0; bj < 2; ++bj) s += dot4(v[ai][bj][m][0]) + dot4(v[ai][bj][m][1]);
                s += __shfl_xor(s, 16); s += __shfl_xor(s, 32);
                if (fq == 0) P[(ai * HALF + wr * 64 + m * 16 + fr) * 4 + wc] = s; }
        asm volatile("s_waitcnt lgkmcnt(0)" ::: "memory"); __builtin_amdgcn_s_barrier(); asm volatile("" ::: "memory");
        const int row = wid * 32 + (lane & 31);
        if (lane < 32) {
            const float t = (P[row * 4] + P[row * 4 + 1]) + (P[row * 4 + 2] + P[row * 4 + 3]);
            unsigned* slot = xbuf + (size_t)(u.pm * BM + row) * 4;
            __hip_atomic_store(slot + u.pn, (__float_as_uint(t) & ~7u) | tag, __ATOMIC_RELAXED, __HIP_MEMORY_SCOPE_AGENT);
            unsigned w0, w1, w2, w3; int it = 0;
            for (;;) {
                w0 = __hip_atomic_load(slot + 0, __ATOMIC_RELAXED, __HIP_MEMORY_SCOPE_AGENT); w1 = __hip_atomic_load(slot + 1, __ATOMIC_RELAXED, __HIP_MEMORY_SCOPE_AGENT);
                w2 = __hip_atomic_load(slot + 2, __ATOMIC_RELAXED, __HIP_MEMORY_SCOPE_AGENT); w3 = __hip_atomic_load(slot + 3, __ATOMIC_RELAXED, __HIP_MEMORY_SCOPE_AGENT);
                const bool ok = ((w0 & 7u) == tag) & ((w1 & 7u) == tag) & ((w2 & 7u) == tag) & ((w3 & 7u) == tag);
                if (ok || ++it > 400000) break;
                __builtin_amdgcn_s_sleep(1);
            }
            S[row] = (__uint_as_float(w0 & ~7u) + __uint_as_float(w1 & ~7u)) + (__uint_as_float(w2 & ~7u) + __uint_as_float(w3 & ~7u));
        }
        asm volatile("s_waitcnt vmcnt(0) lgkmcnt(0)" ::: "memory"); __builtin_amdgcn_s_barrier(); asm volatile("" ::: "memory");
    }
};
__device__ __forceinline__ float bf_lo(unsigned w) { return __uint_as_float(w << 16); }
__device__ __forceinline__ float bf_hi(unsigned w) { return __uint_as_float(w & 0xffff0000u); }
template <bool FINAL> struct EpiRes {
    static constexpr bool PERM = true, AFTER_DRAIN = false;
    bf16_t* HB; const float* gpost; float coef; float* part; float* out; PanelSS ss; PG8_LAS unsigned char* tab;
    __device__ __forceinline__ void operator()(const f32x4 (&acc)[2][2][4][2], const Unit& u, int wr, int wc, int fr, int fq) const {
        const int row0 = u.pm * BM + wr * 64 + fr, col0 = u.pn * BM + wc * 32 + 8 * fq;
        u32x4 pre[4][2];
#pragma unroll
        for (int m = 0; m < 4; ++m)
#pragma unroll
            for (int bj = 0; bj < 2; ++bj) pre[m][bj] = *(const u32x4*)(HB + (size_t)(row0 + m * 16) * 1024 + col0 + bj * HALF);
        f32x4 g[2][2];
#pragma unroll
        for (int bj = 0; bj < 2; ++bj) { g[bj][0] = *(const f32x4*)(gpost + col0 + bj * HALF); g[bj][1] = *(const f32x4*)(gpost + col0 + bj * HALF + 4); }
        ss.run(acc, u, wr, wc, fr, fq, tab);
        u32x4 post[4][2];
#pragma unroll
        for (int m = 0; m < 4; ++m)
#pragma unroll
            for (int bj = 0; bj < 2; ++bj) post[m][bj] = *(const u32x4*)(HB + (size_t)(row0 + HALF + m * 16) * 1024 + col0 + bj * HALF);
        const PG8_LAS float* S = (const PG8_LAS float*)(tab + 4096);
#pragma unroll
        for (int ai = 0; ai < 2; ++ai)
#pragma unroll
            for (int m = 0; m < 4; ++m) {
                const int rl = ai * HALF + wr * 64 + m * 16 + fr, row = u.pm * BM + rl;
                const float rf = __builtin_amdgcn_rsqf(S[rl] * (1.f / 1024.f) + 1e-6f) * coef; float s2 = 0.f;
#pragma unroll
                for (int bj = 0; bj < 2; ++bj) {
                    const u32x4 hw = (ai == 0) ? pre[m][bj] : post[m][bj];
                    f32x4 h0, h1; h0[0] = bf_lo(hw.x); h0[1] = bf_hi(hw.x); h0[2] = bf_lo(hw.y); h0[3] = bf_hi(hw.y); h1[0] = bf_lo(hw.z); h1[1] = bf_hi(hw.z); h1[2] = bf_lo(hw.w); h1[3] = bf_hi(hw.w);
                    h0 = h0 + acc[ai][bj][m][0] * g[bj][0] * rf; h1 = h1 + acc[ai][bj][m][1] * g[bj][1] * rf;
                    if (FINAL) { *(f32x4*)(out + (size_t)row * 1024 + col0 + bj * HALF) = h0; *(f32x4*)(out + (size_t)row * 1024 + col0 + bj * HALF + 4) = h1; }
                    else { s2 += dot4(h0) + dot4(h1); *(u32x4*)(HB + (size_t)row * 1024 + col0 + bj * HALF) = pack8(h0, h1); }
                }
                if (!FINAL) { s2 += __shfl_xor(s2, 16); s2 += __shfl_xor(s2, 32); if (fq == 0) part[(size_t)row * 16 + u.pn * 4 + wc] = s2; }
            }
    }
};

struct EpiUkv {
    static constexpr bool PERM = true, AFTER_DRAIN = false;
    bf16_t* KN; bf16_t* VV; const float* cpart;
    __device__ __forceinline__ void operator()(const f32x4 (&acc)[2][2][4][2], const Unit& u, int wr, int wc, int fr, int fq) const {
        const int row0 = u.pm * BM + wr * 64 + fr, col0 = u.pn * 128 + wc * 32 + 8 * fq;
#pragma unroll
        for (int ai = 0; ai < 2; ++ai)
#pragma unroll
            for (int m = 0; m < 4; ++m) {
                const int row = row0 + ai * HALF + m * 16;
                const f32x4 cp = *(const f32x4*)(cpart + (size_t)row * 4);
                const float rc = __builtin_amdgcn_rsqf(sum4(cp) * (1.f / 256.f) + 1e-6f);
                *(u32x4*)(KN + (size_t)row * 1024 + col0) = pack8(acc[ai][0][m][0] * rc, acc[ai][0][m][1] * rc);
                *(u32x4*)(VV + (size_t)row * 1024 + col0) = pack8(acc[ai][1][m][0] * rc, acc[ai][1][m][1] * rc);
                asm volatile("" ::: "memory");
            }
    }
};
struct EpiUq {
    static constexpr bool PERM = true, AFTER_DRAIN = false;
    bf16_t* Q; const float* qpart; const float* cs; const float* sn;
    __device__ __forceinline__ void operator()(const f32x4 (&acc)[2][2][4][2], const Unit& u, int wr, int wc, int fr, int fq) const {
        const int row0 = u.pm * BM + wr * 64 + fr;
#pragma unroll
        for (int ai = 0; ai < 2; ++ai)
#pragma unroll
            for (int m = 0; m < 4; ++m) {
                const int row = row0 + ai * HALF + m * 16;
                const f32x4 p0 = *(const f32x4*)(qpart + (size_t)row * 8), p1 = *(const f32x4*)(qpart + (size_t)row * 8 + 4);
                const float rq = __builtin_amdgcn_rsqf((sum4(p0) + sum4(p1)) * (1.f / 512.f) + 1e-6f);
                bf16_t* qrow = Q + (size_t)row * 1536;
                if (u.pn < 4) {
#pragma unroll
                    for (int bj = 0; bj < 2; ++bj) *(u32x4*)(qrow + (2 * u.pn + bj) * 192 + wc * 32 + 8 * fq) = pack8(acc[ai][bj][m][0] * rq, acc[ai][bj][m][1] * rq);
                } else {
                    const int head = 4 * (u.pn - 4) + wc;
                    const f32x4 c0 = *(const f32x4*)(cs + (size_t)row * 32 + 8 * fq), c1 = *(const f32x4*)(cs + (size_t)row * 32 + 8 * fq + 4);
                    const f32x4 s0 = *(const f32x4*)(sn + (size_t)row * 32 + 8 * fq), s1 = *(const f32x4*)(sn + (size_t)row * 32 + 8 * fq + 4);
                    const f32x4 a0 = acc[ai][0][m][0] * rq, a1 = acc[ai][0][m][1] * rq, b0 = acc[ai][1][m][0] * rq, b1 = acc[ai][1][m][1] * rq;
                    *(u32x4*)(qrow + head * 192 + 128 + 8 * fq) = pack8(a0 * c0 - b0 * s0, a1 * c1 - b1 * s1);
                    *(u32x4*)(qrow + head * 192 + 160 + 8 * fq) = pack8(b0 * c0 + a0 * s0, b1 * c1 + a1 * s1);
                }
                asm volatile("" ::: "memory");
            }
    }
};

template <class Epi, class Sched, bool ALIGN_EPI = false, bool SP2 = false>
__device__ __forceinline__ void gemm_phase(PG8_LAS unsigned char* lds, const Gemm g, const Sched& S, const Epi& E, const int wv) {
    int tid_ = (wv << 6) | fresh_lane();
    const int tid = tid_, wid = __builtin_amdgcn_readfirstlane(tid >> 6), lane = tid & 63, wr = wid >> 2, wc = wid & 3, fr = lane & 15, fq = lane >> 4;
    const int K = g.K, nt = K / BK;
    unsigned voffA[2], voffB[2];
#pragma unroll
    for (int i = 0; i < 2; ++i) { int R, C; stage_rc(tid * 16 + i * 8192, R, C); const int Rb = Epi::PERM ? ((R & ~31) + perm32(R & 31)) : R;
        voffA[i] = (unsigned)(R * K + C) * 2u; voffB[i] = (unsigned)(Rb * K + C) * 2u; }
    const size_t kstep = (size_t)(BK * 2);
    const size_t hstep = (size_t)HALF * K * 2;
    const size_t tstep = 2 * hstep;
    const unsigned ldsw = (unsigned)wid * 1024u;
    const int aoff = lds_byte(wr * 64 + fr, fq * 8), boff = lds_byte(wc * 32 + fr, fq * 8);
#define PG8_SA(b, h) (((b) * 2 + (h)) * HTB)
#define PG8_SB(b, h) ((4 + (b) * 2 + (h)) * HTB)
#define PG8_STAGE(bufoff, gbase, voff) do { _Pragma("unroll") for (int _i = 0; _i < 2; ++_i) \
        __builtin_amdgcn_global_load_lds((const unsigned*)((const char*)(gbase) + (voff)[_i]), (PG8_LAS unsigned*)(lds + (bufoff) + ldsw + _i * 8192), 16, 0, 0); } while (0)
#define PG8_LDA(dst, b, h) do { _Pragma("unroll") for (int m = 0; m < 4; ++m) _Pragma("unroll") for (int k = 0; k < 2; ++k) dst[m][k] = *(const PG8_LAS bf16x8*)(lds + PG8_SA(b, h) + aoff + m * 2048 + k * 1024); } while (0)
#define PG8_LDB(dst, b, h) do { _Pragma("unroll") for (int n = 0; n < 2; ++n) _Pragma("unroll") for (int k = 0; k < 2; ++k) dst[n][k] = *(const PG8_LAS bf16x8*)(lds + PG8_SB(b, h) + boff + n * 2048 + k * 1024); } while (0)
#define PG8_MMA(ai, bj, At, Bt) do { __builtin_amdgcn_s_setprio(1); _Pragma("unroll") for (int m = 0; m < 4; ++m) _Pragma("unroll") for (int n = 0; n < 2; ++n) _Pragma("unroll") for (int k = 0; k < 2; ++k) \
        acc[ai][bj][m][n] = __builtin_amdgcn_mfma_f32_16x16x32_bf16(Bt[n][k], At[m][k], acc[ai][bj][m][n], 0, 0, 0); __builtin_amdgcn_s_setprio(0); } while (0)
#define PG8_WAIT_V(n) asm volatile("s_waitcnt vmcnt(" #n ")" ::: "memory")
#define PG8_WAIT_L(n) asm volatile("s_waitcnt lgkmcnt(" #n ")" ::: "memory")
#define PG8_BAR __builtin_amdgcn_s_barrier()
#define PG8_SCHED __builtin_amdgcn_sched_barrier(0)
    Unit cur, nxt; int ui = 0;
    if (!S.next(0, cur)) return;
    f32x4 acc[2][2][4][2];
#pragma unroll
    for (int a = 0; a < 2; ++a)
#pragma unroll
        for (int b = 0; b < 2; ++b)
#pragma unroll
            for (int m = 0; m < 4; ++m)
#pragma unroll
                for (int n = 0; n < 2; ++n) acc[a][b][m][n] = (f32x4){0.f, 0.f, 0.f, 0.f};
    bf16x8 At[4][2], B0[2][2], B1[2][2];
    const char* cA = (const char*)g.A + (size_t)cur.pm * tstep; const char* cB = (const char*)g.Bt + (size_t)cur.pn * tstep;
    S.a_ready(cur);
    if constexpr (SP2) {
        PG8_STAGE(PG8_SB(0, 0), cB, voffB); PG8_STAGE(PG8_SB(0, 1), cB + hstep, voffB); PG8_STAGE(PG8_SA(0, 0), cA, voffA); PG8_STAGE(PG8_SA(0, 1), cA + hstep, voffA);
        if (wr == 1) PG8_BAR;
        PG8_WAIT_V(2); PG8_BAR;
        PG8_STAGE(PG8_SB(1, 0), cB + kstep, voffB); PG8_STAGE(PG8_SA(1, 0), cA + kstep, voffA); PG8_STAGE(PG8_SB(1, 1), cB + hstep + kstep, voffB);
        PG8_WAIT_V(6); PG8_BAR;
    } else {
        PG8_STAGE(PG8_SB(0, 0), cB, voffB); PG8_STAGE(PG8_SA(0, 0), cA, voffA); PG8_STAGE(PG8_SB(0, 1), cB + hstep, voffB); PG8_STAGE(PG8_SA(0, 1), cA + hstep, voffA);
        if (wr == 1) PG8_BAR;
        PG8_WAIT_V(4); PG8_BAR;
        PG8_STAGE(PG8_SB(1, 0), cB + kstep, voffB); PG8_STAGE(PG8_SA(1, 0), cA + kstep, voffA); PG8_STAGE(PG8_SB(1, 1), cB + hstep + kstep, voffB);
        PG8_WAIT_V(6); PG8_BAR;
    }
    for (;;) {
        const bool has_next = S.next(ui + 1, nxt);
        const char* nA = has_next ? (const char*)g.A + (size_t)nxt.pm * tstep : cA; const char* nB = has_next ? (const char*)g.Bt + (size_t)nxt.pn * tstep : cB;
        for (int t = 0; t < nt; t += 2) {
            const bool last = (t == nt - 2);
            const char* a1 = cA + (size_t)(t + 1) * kstep;
            const char* a2 = last ? nA : cA + (size_t)(t + 2) * kstep; const char* b2 = last ? nB : cB + (size_t)(t + 2) * kstep;
            const char* a3 = a2 + kstep; const char* b3 = b2 + kstep;
            if (last && has_next) S.a_ready(nxt);
            if constexpr (SP2) {
            PG8_LDB(B0, 0, 0); PG8_LDB(B1, 0, 1); PG8_SCHED; PG8_LDA(At, 0, 0); PG8_STAGE(PG8_SA(1, 1), a1 + hstep, voffA);
            PG8_WAIT_V(8); PG8_WAIT_L(0); PG8_BAR; PG8_MMA(0, 0, At, B0); PG8_MMA(0, 1, At, B1); PG8_BAR; PG8_SCHED;
            PG8_LDA(At, 0, 1); PG8_STAGE(PG8_SB(0, 0), b2, voffB); PG8_STAGE(PG8_SB(0, 1), b2 + hstep, voffB); PG8_STAGE(PG8_SA(0, 0), a2, voffA);
            PG8_WAIT_V(8); PG8_WAIT_L(0); PG8_BAR; PG8_MMA(1, 0, At, B0); PG8_MMA(1, 1, At, B1); PG8_BAR; PG8_SCHED;
            PG8_LDB(B0, 1, 0); PG8_LDB(B1, 1, 1); PG8_SCHED; PG8_LDA(At, 1, 0); PG8_STAGE(PG8_SA(0, 1), a2 + hstep, voffA);
            PG8_WAIT_V(8); PG8_WAIT_L(0); PG8_BAR; PG8_MMA(0, 0, At, B0); PG8_MMA(0, 1, At, B1); PG8_BAR; PG8_SCHED;
            PG8_LDA(At, 1, 1); PG8_STAGE(PG8_SB(1, 0), b3, voffB); PG8_STAGE(PG8_SB(1, 1), b3 + hstep, voffB); PG8_STAGE(PG8_SA(1, 0), a3, voffA);
            PG8_WAIT_V(8); PG8_WAIT_L(0); PG8_BAR; PG8_MMA(1, 0, At, B0); PG8_MMA(1, 1, At, B1); PG8_BAR; PG8_SCHED;
            } else {
            PG8_LDB(B0, 0, 0); PG8_SCHED; PG8_LDA(At, 0, 0); PG8_STAGE(PG8_SA(1, 1), a1 + hstep, voffA);
            PG8_WAIT_L(8); PG8_BAR; PG8_WAIT_L(0); PG8_MMA(0, 0, At, B0); PG8_BAR; PG8_SCHED;
            PG8_LDB(B1, 0, 1); PG8_STAGE(PG8_SB(0, 0), b2, voffB);
            PG8_BAR; PG8_WAIT_L(0); PG8_MMA(0, 1, At, B1); PG8_BAR;
            PG8_LDA(At, 0, 1); PG8_STAGE(PG8_SA(0, 0), a2, voffA);
            PG8_BAR; PG8_WAIT_L(0); PG8_MMA(1, 0, At, B0); PG8_BAR; PG8_SCHED;
            PG8_STAGE(PG8_SB(0, 1), b2 + hstep, voffB);
            PG8_WAIT_V(6); PG8_BAR; PG8_MMA(1, 1, At, B1); PG8_BAR;
            PG8_LDB(B0, 1, 0); PG8_SCHED; PG8_LDA(At, 1, 0); PG8_STAGE(PG8_SA(0, 1), a2 + hstep, voffA);
            PG8_WAIT_L(8); PG8_BAR; PG8_WAIT_L(0); PG8_MMA(0, 0, At, B0); PG8_BAR; PG8_SCHED;
            PG8_LDB(B1, 1, 1); PG8_STAGE(PG8_SB(1, 0), b3, voffB);
            PG8_BAR; PG8_WAIT_L(0); PG8_MMA(0, 1, At, B1); PG8_BAR;
            PG8_LDA(At, 1, 1); PG8_STAGE(PG8_SA(1, 0), a3, voffA);
            PG8_BAR; PG8_WAIT_L(0); PG8_MMA(1, 0, At, B0); PG8_BAR; PG8_SCHED;
            PG8_STAGE(PG8_SB(1, 1), b3 + hstep, voffB);
            PG8_WAIT_V(6); PG8_BAR; PG8_MMA(1, 1, At, B1); PG8_BAR;
            }
        }
        if constexpr (ALIGN_EPI) { if (wr == 0) PG8_BAR; }
        if constexpr (!Epi::AFTER_DRAIN) { E(acc, cur, wr, wc, fr, fq); S.done(cur); }
        if (!has_next) break;
#pragma unroll
        for (int a = 0; a < 2; ++a)
#pragma unroll
            for (int b = 0; b < 2; ++b)
#pragma unroll
                for (int m = 0; m < 4; ++m)
#pragma unroll
                    for (int n = 0; n < 2; ++n) acc[a][b][m][n] = (f32x4){0.f, 0.f, 0.f, 0.f};
        cur = nxt; cA = nA; cB = nB; ++ui;
        if constexpr (ALIGN_EPI) { if (wr == 1) PG8_BAR; }
    }
    PG8_WAIT_V(0);
    if constexpr (!ALIGN_EPI) { if (wr == 0) PG8_BAR; }
    PG8_BAR;
    if constexpr (Epi::AFTER_DRAIN) { E.fused(acc, cur, wr, wc, fr, fq, lds, wid, lane); S.done(cur); }
#undef PG8_SA
#undef PG8_SB
#undef PG8_STAGE
#undef PG8_LDA
#undef PG8_LDB
#undef PG8_MMA
#undef PG8_WAIT_V
#undef PG8_WAIT_L
#undef PG8_BAR
#undef PG8_SCHED
}
}

#define LAS __attribute__((address_space(3)))
typedef unsigned short bf16;
typedef unsigned v4u __attribute__((ext_vector_type(4)));
typedef unsigned v2u __attribute__((ext_vector_type(2)));
typedef float f32x4 __attribute__((ext_vector_type(4)));
typedef float f32x16 __attribute__((ext_vector_type(16)));
typedef short bf16x8 __attribute__((ext_vector_type(8)));
typedef short s16x4 __attribute__((ext_vector_type(4)));

constexpr int NWAVES = 8, NTHREADS = 512;
constexpr int T = 32768, D = 1024, FF = 2816, SEQ = 2048, NB = 16;
constexpr int LDS_BYTES = 147456;
constexpr size_t MiB = 1u << 20;
constexpr size_t WS_WGU = 0, WS_WD = 44 * MiB, WS_WIN = 66 * MiB, WS_WOUT = 74 * MiB, WS_WDKV = 78 * MiB, WS_WUKV = 79 * MiB, WS_WDQ = 80 * MiB, WS_WUQ = 81 * MiB, WS_WO = 83 * MiB, WS_WSM = 85 * MiB;
constexpr size_t WS_HNF = 88 * MiB;
constexpr size_t WS_BIG = 152 * MiB;
constexpr size_t WS_HID = WS_BIG;
constexpr size_t WS_U = WS_BIG, WS_V = WS_BIG + 128 * MiB;
constexpr size_t WS_Q = WS_BIG, WS_QC = WS_BIG + 96 * MiB, WS_O = WS_BIG + 128 * MiB;
constexpr size_t WS_C = 328 * MiB;
constexpr size_t WS_KN = 344 * MiB, WS_VV = 408 * MiB, WS_KR = 472 * MiB;
constexpr size_t WS_PART = 476 * MiB, WS_VSTAT = 478 * MiB, WS_CPART = 486 * MiB, WS_QPART = 487 * MiB, WS_COS = 488 * MiB, WS_SIN = 492 * MiB, WS_BAR = 496 * MiB, WS_XBUF = 496 * MiB + 131072, WS_END = 497 * MiB;
constexpr size_t WGU_ELEMS = (size_t)2 * FF * D, WD_ELEMS = (size_t)D * FF;

__device__ __forceinline__ float wave_sum(float v) {
#pragma unroll
    for (int o = 1; o < 64; o <<= 1) v += __shfl_xor(v, o);
    return v;
}
__device__ __forceinline__ float bf2f(unsigned short b) { return __uint_as_float(((unsigned)b) << 16); }
__device__ __forceinline__ float bflo(unsigned w) { return __uint_as_float(w << 16); }
__device__ __forceinline__ float bfhi(unsigned w) { return __uint_as_float(w & 0xffff0000u); }
__device__ __forceinline__ unsigned pk2(float lo, float hi) { return pg8::cvt_pk_bf16(lo, hi); }

__device__ __forceinline__ int map_row(int kind, int n) {
    if (kind == 0) return n;
    if (kind == 1) return 256 * (n >> 7) + (n & 127);
    if (kind == 2) return 256 * (n >> 7) + 128 + (n & 127);
    if (kind == 3) { if (n < 256) return n; const int i = n - 256; return 256 + 128 * (i >> 5) + (i & 31); }
    { const int h = n / 192, j = n - h * 192; if (j < 128) return h * 128 + j; const int i = j - 128; return 1024 + 256 * (h >> 2) + 128 * (i >> 5) + 32 * (h & 3) + (i & 31); }
}
__device__ __forceinline__ void transpose_item(const float* W, int K, int N, const float* gain, float scale, bf16* WT, int kind, LAS float* scr, int item, int lane) {
    const int nblk = N / 64, kb = item / nblk, nb = item % nblk, k0 = 64 * kb, n0 = 64 * nb;
    f32x4 v[16];
#pragma unroll
    for (int i = 0; i < 16; ++i) v[i] = __builtin_nontemporal_load((const f32x4*)(W + (size_t)(k0 + 4 * i + (lane >> 4)) * N + n0 + 4 * (lane & 15)));
#pragma unroll
    for (int i = 0; i < 16; ++i) { const int kk = 4 * i + (lane >> 4); const float gk = gain ? gain[k0 + kk] * scale : scale; LAS float* d = scr + kk * 65 + 4 * (lane & 15);
        d[0] = v[i][0] * gk; d[1] = v[i][1] * gk; d[2] = v[i][2] * gk; d[3] = v[i][3] * gk; }
    asm volatile("s_waitcnt lgkmcnt(0)" ::: "memory");
    const int c = lane & 7;
#pragma unroll
    for (int j = 0; j < 8; ++j) { const int n = (lane >> 3) + 8 * j; const LAS float* s = scr + (8 * c) * 65 + n;
        v4u o; o.x = pk2(s[0 * 65], s[1 * 65]); o.y = pk2(s[2 * 65], s[3 * 65]); o.z = pk2(s[4 * 65], s[5 * 65]); o.w = pk2(s[6 * 65], s[7 * 65]);
        *(v4u*)(WT + (size_t)map_row(kind, n0 + n) * K + k0 + 8 * c) = o; }
    asm volatile("s_waitcnt lgkmcnt(0)" ::: "memory");
}

struct Params { const float* in[23]; float* out; unsigned char* ws; };

template <int MODE>
__device__ __forceinline__ void row_pass(const float* x, bf16* hb, const bf16* f, const float* part, const float* gpost, float coef, float* rs, float* out, const int wv) {
    int tid_ = (wv << 6) | pg8::fresh_lane(); const int lane = tid_ & 63, gw = blockIdx.x * NWAVES + __builtin_amdgcn_readfirstlane(tid_ >> 6), NGW = gridDim.x * NWAVES;
    for (int row = gw; row < T; row += NGW) {
        f32x4 hv[4];
        if (MODE == 0) {
#pragma unroll
            for (int j = 0; j < 4; ++j) hv[j] = __builtin_nontemporal_load((const f32x4*)(x + (size_t)row * D + 256 * j + 4 * lane));
        } else {
            const f32x4 p0 = *(const f32x4*)(part + (size_t)row * 16), p1 = *(const f32x4*)(part + (size_t)row * 16 + 4), p2 = *(const f32x4*)(part + (size_t)row * 16 + 8), p3 = *(const f32x4*)(part + (size_t)row * 16 + 12);
            const float ssf = (pg8::sum4(p0) + pg8::sum4(p1)) + (pg8::sum4(p2) + pg8::sum4(p3));
            const float rf = __builtin_amdgcn_rsqf(ssf * (1.f / D) + 1e-6f) * coef;
#pragma unroll
            for (int j = 0; j < 4; ++j) {
                const v2u hw = *(const v2u*)(hb + (size_t)row * D + 256 * j + 4 * lane);
                const v2u fw = *(const v2u*)(f + (size_t)row * D + 256 * j + 4 * lane);
                const f32x4 g = *(const f32x4*)(gpost + 256 * j + 4 * lane);
                f32x4 fv, h0; fv[0] = bflo(fw.x); fv[1] = bfhi(fw.x); fv[2] = bflo(fw.y); fv[3] = bfhi(fw.y); h0[0] = bflo(hw.x); h0[1] = bfhi(hw.x); h0[2] = bflo(hw.y); h0[3] = bfhi(hw.y);
                hv[j] = h0 + fv * g * rf;
            }
        }
        if (MODE == 2) {
#pragma unroll
            for (int j = 0; j < 4; ++j) *(f32x4*)(out + (size_t)row * D + 256 * j + 4 * lane) = hv[j];
        } else {
            float ss = 0.f;
#pragma unroll
            for (int j = 0; j < 4; ++j) ss += pg8::dot4(hv[j]);
            ss = wave_sum(ss);
            if (lane < 16) rs[(size_t)row * 16 + lane] = lane == 0 ? ss : 0.f;
#pragma unroll
            for (int j = 0; j < 4; ++j) { v2u o; o.x = pk2(hv[j][0], hv[j][1]); o.y = pk2(hv[j][2], hv[j][3]); *(v2u*)(hb + (size_t)row * D + 256 * j + 4 * lane) = o; }
        }
    }
}

__device__ __forceinline__ void prologue(const Params& p, LAS unsigned char* lds, const int wv) {
    int tid_ = (wv << 6) | pg8::fresh_lane(); const int lane = tid_ & 63, wave = __builtin_amdgcn_readfirstlane(tid_ >> 6), gw = blockIdx.x * NWAVES + wave, NGW = gridDim.x * NWAVES;
    unsigned char* ws = p.ws;
    LAS float* scr = (LAS float*)(lds + wave * 16640);
    {
        constexpr int I_FF = (D / 64) * (FF / 64);
        constexpr int C0 = 4 * I_FF, C1 = 8 * I_FF, C2 = 12 * I_FF, C3 = C2 + 16 * 64, C4 = C3 + 32 * 16, C5 = C4 + 16 * 5, C6 = C5 + 4 * 32, C7 = C6 + 16 * 8, C8 = C7 + 8 * 24, C9 = C8 + 16 * 16;
        for (int it = gw; it < C9; it += NGW) {
            const float* W; const float* gain = nullptr; bf16* dst; int K, N, kind = 0, li; float scale = 1.f;
            if (it < C0)      { const int j = it / I_FF; li = it - j * I_FF; W = p.in[4] + (size_t)j * D * FF; gain = p.in[2] + j * D; dst = (bf16*)(ws + WS_WGU) + j * WGU_ELEMS; K = D; N = FF; kind = 1; }
            else if (it < C1) { const int j = (it - C0) / I_FF; li = it - C0 - j * I_FF; W = p.in[5] + (size_t)j * D * FF; gain = p.in[2] + j * D; dst = (bf16*)(ws + WS_WGU) + j * WGU_ELEMS; K = D; N = FF; kind = 2; }
            else if (it < C2) { const int j = (it - C1) / I_FF; li = it - C1 - j * I_FF; W = p.in[6] + (size_t)j * FF * D; dst = (bf16*)(ws + WS_WD) + j * WD_ELEMS; K = FF; N = D; }
            else if (it < C3) { li = it - C2; W = p.in[9]; gain = p.in[7]; dst = (bf16*)(ws + WS_WIN); K = D; N = 4096; }
            else if (it < C4) { li = it - C3; W = p.in[14]; dst = (bf16*)(ws + WS_WOUT); K = 2048; N = D; }
            else if (it < C5) { li = it - C4; W = p.in[16]; gain = p.in[15]; dst = (bf16*)(ws + WS_WDKV); K = D; N = 320; kind = 3; }
            else if (it < C6) { li = it - C5; W = p.in[18]; gain = p.in[17]; dst = (bf16*)(ws + WS_WUKV); K = 256; N = 2048; }
            else if (it < C7) { li = it - C6; W = p.in[19]; gain = p.in[7] + D; dst = (bf16*)(ws + WS_WDQ); K = D; N = 512; }
            else if (it < C8) { li = it - C7; W = p.in[21]; gain = p.in[20]; dst = (bf16*)(ws + WS_WUQ); K = 512; N = 1536; kind = 4; scale = 0.07216878364870322f * 1.4426950408889634f; }
            else              { li = it - C8; W = p.in[22]; dst = (bf16*)(ws + WS_WO); K = D; N = D; }
            transpose_item(W, K, N, gain, scale, dst, kind, scr, li, lane);
        }
    }
    {
        const float* wsrc = p.in[12]; bf16* wm = (bf16*)(ws + WS_WSM);
        for (int i = gw * 64 + lane; i < 16 * 128 * 128 / 4; i += NGW * 64) {
            const f32x4 v = *(const f32x4*)(wsrc + (size_t)i * 4); const int e = i * 4, t = (e >> 7) & 127, c = e & 127;
            v2u o; o.x = pk2(c <= t ? v[0] : 0.f, c + 1 <= t ? v[1] : 0.f); o.y = pk2(c + 2 <= t ? v[2] : 0.f, c + 3 <= t ? v[3] : 0.f);
            *(v2u*)(wm + (size_t)e) = o;
        }
    }
    {
        const int* pos = (const int*)p.in[1]; float* cs = (float*)(ws + WS_COS); float* sn = (float*)(ws + WS_SIN);
        for (int i = gw * 64 + lane; i < T * 32; i += NGW * 64) {
            const int tok = i >> 5, k = i & 31;
            const float inv = __builtin_exp2f(-(float)(2 * k) * (1.f / 64.f) * 13.287712379549449f);
            const float ang = (float)pos[tok] * inv;
            const double a = (double)ang; const double kk = __builtin_rint(a * 0.15915494309189535); const float r = (float)(a - kk * 6.283185307179586);
            cs[i] = __builtin_cosf(r); sn[i] = __builtin_sinf(r);
        }
    }
    row_pass<0>(p.in[0], (bf16*)(ws + WS_HNF), nullptr, nullptr, nullptr, 0.f, (float*)(ws + WS_PART), nullptr, wv);
}

__device__ __forceinline__ s16x4 vtr(const LAS unsigned char* p) { return __builtin_amdgcn_ds_read_tr16_b64_v4i16((LAS s16x4*)p); }
__device__ __forceinline__ bf16x8 tr_frag(const LAS unsigned char* tile, int str, int k0, int n0, int lane) {
    const LAS unsigned char* a = tile + (k0 + 8 * (lane >> 5) + ((lane & 15) >> 2)) * str + (n0 + 16 * ((lane >> 4) & 1) + 4 * (lane & 3)) * 2;
    const s16x4 lo = vtr(a), hi4 = vtr(a + 4 * str);
    return (bf16x8){lo[0], lo[1], lo[2], lo[3], hi4[0], hi4[1], hi4[2], hi4[3]};
}
__device__ __forceinline__ int crow(int r, int hi) { return (r & 3) + 8 * (r >> 2) + 4 * hi; }

constexpr int VNSTR = 320;
__device__ __forceinline__ void gate_ln_store(LAS unsigned char* buf, const LAS float* stats, const v4u (&raw)[4], const float* lng, const float* lnb, int g, int tid) {
#pragma unroll
    for (int i = 0; i < 4; ++i) {
        const int idx = tid + 512 * i, row = idx >> 4, ch = idx & 15;
        const float mean = stats[2 * row], rstd = stats[2 * row + 1];
        const f32x4 g0 = *(const f32x4*)(lng + g * 128 + ch * 8), g1 = *(const f32x4*)(lng + g * 128 + ch * 8 + 4);
        const f32x4 b0 = *(const f32x4*)(lnb + g * 128 + ch * 8), b1 = *(const f32x4*)(lnb + g * 128 + ch * 8 + 4);
        f32x4 x0, x1; x0[0] = bflo(raw[i].x); x0[1] = bfhi(raw[i].x); x0[2] = bflo(raw[i].y); x0[3] = bfhi(raw[i].y); x1[0] = bflo(raw[i].z); x1[1] = bfhi(raw[i].z); x1[2] = bflo(raw[i].w); x1[3] = bfhi(raw[i].w);
        x0 = (x0 - mean) * rstd * g0 + b0; x1 = (x1 - mean) * rstd * g1 + b1;
        *(LAS v4u*)(buf + row * VNSTR + ch * 16) = pg8::pack8(x0, x1);
    }
}
__device__ __forceinline__ void gate_load_v(v4u (&raw)[4], const bf16* V, int tok0, int g, int tid) {
#pragma unroll
    for (int i = 0; i < 4; ++i) { const int idx = tid + 512 * i, row = idx >> 4, ch = idx & 15; raw[i] = __builtin_nontemporal_load((const v4u*)(V + (size_t)(tok0 + row) * 2048 + g * 128 + ch * 8)); }
}
__device__ __forceinline__ void gate_phase(const Params& p, LAS unsigned char* lds, const int wv) {
    int tid_ = (wv << 6) | pg8::fresh_lane(); const int tid = tid_, lane = tid_ & 63, wave = __builtin_amdgcn_readfirstlane(tid_ >> 6);
    unsigned char* ws = p.ws;
    bf16* U = (bf16*)(ws + WS_U); const bf16* V = (const bf16*)(ws + WS_V); const float* vstat = (const float*)(ws + WS_VSTAT);
    const bf16* Wm = (const bf16*)(ws + WS_WSM); const float* lng = p.in[10]; const float* lnb = p.in[11]; const float* bs = p.in[13];
    LAS float* stats = (LAS float*)(lds + 2 * 128 * VNSTR);
    LAS float* wscr = (LAS float*)(lds + 2 * 128 * VNSTR + 1024) + wave * (32 * 33);
    const int r32 = lane & 31, hi = lane >> 5, tq = wave & 3, dh = wave >> 2;
    const int nks = 2 * tq + 2;
    for (int chunk = blockIdx.x; chunk < T / 128; chunk += gridDim.x) {
        const int tok0 = chunk * 128;
        v4u raw[4];
        gate_load_v(raw, V, tok0, 0, tid);
        __syncthreads();
        if (tid < 128) {
            const float* sp = vstat + (size_t)(tok0 + tid) * 64; float s1 = 0.f, s2 = 0.f;
#pragma unroll
            for (int i = 0; i < 16; ++i) { const f32x4 v = *(const f32x4*)(sp + 4 * i); s1 += v[0] + v[2]; s2 += v[1] + v[3]; }
            const float mean = s1 * (1.f / 2048.f), var = s2 * (1.f / 2048.f) - mean * mean;
            stats[2 * tid] = mean; stats[2 * tid + 1] = __builtin_amdgcn_rsqf(var + 1e-5f);
        }
        __syncthreads();
        gate_ln_store(lds, stats, raw, lng, lnb, 0, tid);
        bf16x8 wf[8];
        { const bf16* wrow = Wm + ((size_t)0 * 128 + 32 * tq + r32) * 128 + 8 * hi;
#pragma unroll
          for (int ks = 0; ks < 8; ++ks) if (ks < nks) wf[ks] = *(const bf16x8*)(wrow + 16 * ks); }
        __syncthreads();
        const int tl = lane >> 1, ds0 = (lane & 1) * 16;
        for (int g = 0; g < 16; ++g) {
            const LAS unsigned char* buf = lds + (g & 1) * 128 * VNSTR;
            if (g + 1 < 16) gate_load_v(raw, V, tok0, g + 1, tid);
            bf16* up = U + (size_t)(tok0 + 32 * tq + tl) * 2048 + g * 128 + 64 * dh + ds0;
            const v4u ua0 = *(const v4u*)up, ua1 = *(const v4u*)(up + 8), ub0 = *(const v4u*)(up + 32), ub1 = *(const v4u*)(up + 40);
            float bias[16];
#pragma unroll
            for (int r = 0; r < 16; ++r) bias[r] = bs[g * 128 + 32 * tq + crow(r, hi)];
            f32x16 acc0 = {}, acc1 = {};
#pragma unroll
            for (int ks = 0; ks < 8; ++ks) if (ks < nks) {
                const bf16x8 b0 = tr_frag(buf, VNSTR, 16 * ks, 64 * dh, lane), b1 = tr_frag(buf, VNSTR, 16 * ks, 64 * dh + 32, lane);
                acc0 = __builtin_amdgcn_mfma_f32_32x32x16_bf16(wf[ks], b0, acc0, 0, 0, 0);
                acc1 = __builtin_amdgcn_mfma_f32_32x32x16_bf16(wf[ks], b1, acc1, 0, 0, 0);
            }
            if (g + 1 < 16) {
                const bf16* wrow = Wm + ((size_t)(g + 1) * 128 + 32 * tq + r32) * 128 + 8 * hi;
#pragma unroll
                for (int ks = 0; ks < 8; ++ks) if (ks < nks) wf[ks] = *(const bf16x8*)(wrow + 16 * ks);
                gate_ln_store(lds + ((g + 1) & 1) * 128 * VNSTR, stats, raw, lng, lnb, g + 1, tid);
            }
#pragma unroll
            for (int nb = 0; nb < 2; ++nb) {
#pragma unroll
                for (int r = 0; r < 16; ++r) wscr[crow(r, hi) * 33 + r32] = (nb == 0 ? acc0[r] : acc1[r]) + bias[r];
                asm volatile("s_waitcnt lgkmcnt(0)" ::: "memory");
                const v4u u0 = nb == 0 ? ua0 : ub0, u1 = nb == 0 ? ua1 : ub1;
                const LAS float* sp = wscr + tl * 33 + ds0;
                v4u o0, o1;
                o0.x = pk2(bflo(u0.x) * sp[0], bfhi(u0.x) * sp[1]); o0.y = pk2(bflo(u0.y) * sp[2], bfhi(u0.y) * sp[3]); o0.z = pk2(bflo(u0.z) * sp[4], bfhi(u0.z) * sp[5]); o0.w = pk2(bflo(u0.w) * sp[6], bfhi(u0.w) * sp[7]);
                o1.x = pk2(bflo(u1.x) * sp[8], bfhi(u1.x) * sp[9]); o1.y = pk2(bflo(u1.y) * sp[10], bfhi(u1.y) * sp[11]); o1.z = pk2(bflo(u1.z) * sp[12], bfhi(u1.z) * sp[13]); o1.w = pk2(bflo(u1.w) * sp[14], bfhi(u1.w) * sp[15]);
                *(v4u*)(up + 32 * nb) = o0; *(v4u*)(up + 32 * nb + 8) = o1;
                asm volatile("s_waitcnt lgkmcnt(0)" ::: "memory");
            }
            __syncthreads();
        }
    }
}

constexpr int KNSTR = 272, KRSTR = 144, VSTR = 320, ATT_KR = 64 * KNSTR, ATT_V = ATT_KR + 64 * KRSTR, ATT_BUF = ATT_V + 64 * VSTR;
struct AttStage { v4u k0, k1, k2, v0, v1; };
__device__ __forceinline__ void att_load(AttStage& s, const unsigned char* knb, const unsigned char* krb, const unsigned char* vvb, int tid) {
    const int r0 = tid >> 4, c0 = tid & 15;
    s.k0 = *(const v4u*)(knb + (size_t)r0 * 2048 + c0 * 16); s.k1 = *(const v4u*)(knb + (size_t)(32 + r0) * 2048 + c0 * 16);
    s.k2 = *(const v4u*)(krb + (size_t)(tid >> 3) * 128 + (tid & 7) * 16);
    s.v0 = *(const v4u*)(vvb + (size_t)r0 * 2048 + c0 * 16); s.v1 = *(const v4u*)(vvb + (size_t)(32 + r0) * 2048 + c0 * 16);
}
__device__ __forceinline__ void att_store(const AttStage& s, LAS unsigned char* buf, int tid) {
    const int r0 = tid >> 4, c0 = tid & 15;
    *(LAS v4u*)(buf + r0 * KNSTR + c0 * 16) = s.k0; *(LAS v4u*)(buf + (32 + r0) * KNSTR + c0 * 16) = s.k1;
    *(LAS v4u*)(buf + ATT_KR + (tid >> 3) * KRSTR + (tid & 7) * 16) = s.k2;
    *(LAS v4u*)(buf + ATT_V + r0 * VSTR + c0 * 16) = s.v0; *(LAS v4u*)(buf + ATT_V + (32 + r0) * VSTR + c0 * 16) = s.v1;
}
#define ATT_SB() __builtin_amdgcn_sched_barrier(0)
__device__ __forceinline__ void att_unit(LAS unsigned char* lds, const bf16* Q, const bf16* KN, const bf16* KR, const bf16* VV, bf16* O, int b, int h, int qb, int tid, int wave, int lane) {
    const int r32 = lane & 31, hi = lane >> 5;
    const int q0 = qb * 256, tok0 = b * SEQ, NT = 4 * qb + 4;
    const int qw0 = q0 + 32 * wave, qpos = qw0 + r32;
    const int prow = (r32 & 19) | ((r32 & 4) << 1) | ((r32 & 8) >> 1);
    const unsigned char* knb = (const unsigned char*)(KN + (size_t)tok0 * 1024 + h * 128);
    const unsigned char* krb = (const unsigned char*)(KR + (size_t)tok0 * 64);
    const unsigned char* vvb = (const unsigned char*)(VV + (size_t)tok0 * 1024 + h * 128);
    bf16x8 qf[12];
    { const bf16* qp = Q + (size_t)(tok0 + qpos) * 1536 + h * 192 + hi * 8;
#pragma unroll
      for (int d0 = 0; d0 < 12; ++d0) qf[d0] = *(const bf16x8*)(qp + d0 * 16); }
    f32x16 o0 = {}, o1 = {}, o2 = {}, o3 = {};
    float mrun = -1e30f, lrun = 0.f;
    AttStage st;
    att_load(st, knb, krb, vvb, tid);
    __syncthreads();
    att_store(st, lds, tid);
    __syncthreads();
    const int koff = prow * KNSTR + hi * 16, roff = ATT_KR + prow * KRSTR + hi * 16;
    const int voff = ATT_V + (8 * hi + ((lane & 15) >> 2)) * VSTR + (16 * ((lane >> 4) & 1) + 4 * (lane & 3)) * 2;
    for (int t = 0; t < NT; ++t) {
        const int cur = t & 1;
        const LAS unsigned char* bufc = lds + cur * ATT_BUF;
        if (t + 1 < NT) att_load(st, knb + (size_t)(t + 1) * 64 * 2048, krb + (size_t)(t + 1) * 64 * 128, vvb + (size_t)(t + 1) * 64 * 2048, tid);
        const int kv0 = 64 * t;
#pragma unroll
        for (int kb = 0; kb < 2; ++kb) {
            const int kvb = kv0 + 32 * kb;
            if (kvb <= qw0 + 31) {
                const LAS unsigned char* kp = bufc + kb * 32 * KNSTR + koff;
                const LAS unsigned char* rp = bufc + kb * 32 * KRSTR + roff;
                const LAS unsigned char* vp = bufc + kb * 32 * VSTR + voff;
                bf16x8 ka[4], kc[2];
#pragma unroll
                for (int i = 0; i < 4; ++i) ka[i] = *(const LAS bf16x8*)(kp + i * 32);
#pragma unroll
                for (int i = 0; i < 2; ++i) kc[i] = *(const LAS bf16x8*)(kp + 128 + i * 32);
                ATT_SB();
                f32x16 s = {};
                __builtin_amdgcn_s_setprio(1);
#pragma unroll
                for (int i = 0; i < 4; ++i) s = __builtin_amdgcn_mfma_f32_32x32x16_bf16(ka[i], qf[i], s, 0, 0, 0);
#pragma unroll
                for (int i = 0; i < 2; ++i) ka[i] = *(const LAS bf16x8*)(kp + 192 + i * 32);
#pragma unroll
                for (int i = 0; i < 2; ++i) ka[2 + i] = *(const LAS bf16x8*)(rp + i * 32);
                ATT_SB();
#pragma unroll
                for (int i = 0; i < 2; ++i) s = __builtin_amdgcn_mfma_f32_32x32x16_bf16(kc[i], qf[4 + i], s, 0, 0, 0);
#pragma unroll
                for (int i = 0; i < 2; ++i) kc[i] = *(const LAS bf16x8*)(rp + 64 + i * 32);
                ATT_SB();
#pragma unroll
                for (int i = 0; i < 2; ++i) s = __builtin_amdgcn_mfma_f32_32x32x16_bf16(ka[i], qf[6 + i], s, 0, 0, 0);
#pragma unroll
                for (int i = 0; i < 2; ++i) s = __builtin_amdgcn_mfma_f32_32x32x16_bf16(ka[2 + i], qf[8 + i], s, 0, 0, 0);
                ATT_SB();
#pragma unroll
                for (int i = 0; i < 2; ++i) s = __builtin_amdgcn_mfma_f32_32x32x16_bf16(kc[i], qf[10 + i], s, 0, 0, 0);
                __builtin_amdgcn_s_setprio(0);
                s16x4 va[8], vb[8];
                ATT_SB();
                if (kvb + 31 > qw0) {
                    asm volatile("");
#pragma unroll
                    for (int r = 0; r < 16; ++r) { const int kv = kvb + 16 * (r >> 3) + 8 * hi + (r & 7); if (kv > qpos) s[r] = -1e30f; }
                }
                float mx = fmaxf(fmaxf(s[0], s[1]), fmaxf(s[2], s[3]));
#pragma unroll
                for (int r = 4; r < 16; r += 4) mx = fmaxf(mx, fmaxf(fmaxf(s[r], s[r + 1]), fmaxf(s[r + 2], s[r + 3])));
                { const auto rr = __builtin_amdgcn_permlane32_swap(__float_as_uint(mx), __float_as_uint(mx), false, false); mx = fmaxf(__uint_as_float(rr[0]), __uint_as_float(rr[1])); }
                if (__any(mx > mrun + 8.f)) {
                    const float mnew = fmaxf(mrun, mx), alpha = __builtin_amdgcn_exp2f(mrun - mnew);
                    mrun = mnew; lrun *= alpha; o0 *= alpha; o1 *= alpha; o2 *= alpha; o3 *= alpha;
                }
                float ls = 0.f;
#pragma unroll
                for (int r = 0; r < 16; ++r) { s[r] = __builtin_amdgcn_exp2f(s[r] - mrun); ls += s[r]; }
                lrun += ls;
                v4u pa, pb;
                pa.x = pk2(s[0], s[1]); pa.y = pk2(s[2], s[3]); pa.z = pk2(s[4], s[5]); pa.w = pk2(s[6], s[7]);
                pb.x = pk2(s[8], s[9]); pb.y = pk2(s[10], s[11]); pb.z = pk2(s[12], s[13]); pb.w = pk2(s[14], s[15]);
                const bf16x8 p0 = __builtin_bit_cast(bf16x8, pa), p1 = __builtin_bit_cast(bf16x8, pb);
#pragma unroll
                for (int d = 0; d < 4; ++d) { va[2 * d] = vtr(vp + d * 64); va[2 * d + 1] = vtr(vp + d * 64 + 4 * VSTR); }
#pragma unroll
                for (int d = 0; d < 4; ++d) { vb[2 * d] = vtr(vp + 16 * VSTR + d * 64); vb[2 * d + 1] = vtr(vp + 20 * VSTR + d * 64); }
#define VF(x, d) (bf16x8){x[2 * d][0], x[2 * d][1], x[2 * d][2], x[2 * d][3], x[2 * d + 1][0], x[2 * d + 1][1], x[2 * d + 1][2], x[2 * d + 1][3]}
                __builtin_amdgcn_s_setprio(1);
                o0 = __builtin_amdgcn_mfma_f32_32x32x16_bf16(VF(va, 0), p0, o0, 0, 0, 0);
                o1 = __builtin_amdgcn_mfma_f32_32x32x16_bf16(VF(va, 1), p0, o1, 0, 0, 0);
                o2 = __builtin_amdgcn_mfma_f32_32x32x16_bf16(VF(va, 2), p0, o2, 0, 0, 0);
                o3 = __builtin_amdgcn_mfma_f32_32x32x16_bf16(VF(va, 3), p0, o3, 0, 0, 0);
                o0 = __builtin_amdgcn_mfma_f32_32x32x16_bf16(VF(vb, 0), p1, o0, 0, 0, 0);
                o1 = __builtin_amdgcn_mfma_f32_32x32x16_bf16(VF(vb, 1), p1, o1, 0, 0, 0);
                o2 = __builtin_amdgcn_mfma_f32_32x32x16_bf16(VF(vb, 2), p1, o2, 0, 0, 0);
                o3 = __builtin_amdgcn_mfma_f32_32x32x16_bf16(VF(vb, 3), p1, o3, 0, 0, 0);
                __builtin_amdgcn_s_setprio(0);
#undef VF
                ATT_SB();
            }
        }
        if (t + 1 < NT) att_store(st, lds + (cur ^ 1) * ATT_BUF, tid);
        __syncthreads();
    }
    lrun += __shfl_xor(lrun, 32);
    const float inv = 1.f / lrun;
    bf16* op = O + (size_t)(tok0 + qpos) * 1024 + h * 128 + 4 * hi;
#pragma unroll
    for (int g4 = 0; g4 < 4; ++g4) {
        v2u w;
        w.x = pk2(o0[4 * g4] * inv, o0[4 * g4 + 1] * inv); w.y = pk2(o0[4 * g4 + 2] * inv, o0[4 * g4 + 3] * inv); *(v2u*)(op + 0 + 8 * g4) = w;
        w.x = pk2(o1[4 * g4] * inv, o1[4 * g4 + 1] * inv); w.y = pk2(o1[4 * g4 + 2] * inv, o1[4 * g4 + 3] * inv); *(v2u*)(op + 32 + 8 * g4) = w;
        w.x = pk2(o2[4 * g4] * inv, o2[4 * g4 + 1] * inv); w.y = pk2(o2[4 * g4 + 2] * inv, o2[4 * g4 + 3] * inv); *(v2u*)(op + 64 + 8 * g4) = w;
        w.x = pk2(o3[4 * g4] * inv, o3[4 * g4 + 1] * inv); w.y = pk2(o3[4 * g4 + 2] * inv, o3[4 * g4 + 3] * inv); *(v2u*)(op + 96 + 8 * g4) = w;
    }
}
__device__ __forceinline__ void att_phase(const Params& p, LAS unsigned char* lds, const int wv) {
    int tid_ = (wv << 6) | pg8::fresh_lane(); const int tid = tid_, lane = tid_ & 63, wave = __builtin_amdgcn_readfirstlane(tid_ >> 6);
    unsigned char* ws = p.ws;
    const bf16* Q = (const bf16*)(ws + WS_Q); const bf16* KN = (const bf16*)(ws + WS_KN); const bf16* KR = (const bf16*)(ws + WS_KR); const bf16* VV = (const bf16*)(ws + WS_VV); bf16* O = (bf16*)(ws + WS_O);
    if (gridDim.x == 256) {
        const int x = blockIdx.x & 7, r = blockIdx.x >> 3, j = r >> 3, q = r & 7;
#pragma unroll 1
        for (int k = 0; k < 4; ++k) {
            const int bh = x * 16 + 4 * k + j, qb = (k & 1) ? 7 - q : q;
            att_unit(lds, Q, KN, KR, VV, O, bh >> 3, bh & 7, qb, tid, wave, lane);
        }
    } else {
        for (int un = blockIdx.x; un < NB * 8 * 8; un += gridDim.x) att_unit(lds, Q, KN, KR, VV, O, un >> 6, (un >> 3) & 7, un & 7, tid, wave, lane);
    }
}

#define XB_TMO      128
#define XB_XCNT(j)  (256  + 64 * (j))
#define XB_XSUB(j)  (1280 + 64 * (j))
#define XB_XGEN(j)  (2304 + 64 * (j))
#define XB_TOP      3328
#define XB_TOPGEN   3392
#define XCD_BAR_WORDS 3456
#define XB_SPIN_CAP (1u << 18)

__device__ __forceinline__ unsigned xb_ld(unsigned* p)              { return __hip_atomic_load(p, __ATOMIC_RELAXED, __HIP_MEMORY_SCOPE_AGENT); }
__device__ __forceinline__ unsigned xb_add(unsigned* p, unsigned v) { return __hip_atomic_fetch_add(p, v, __ATOMIC_RELAXED, __HIP_MEMORY_SCOPE_AGENT); }
__device__ __forceinline__ unsigned xb_xcc_id() { return (unsigned)__builtin_amdgcn_s_getreg((3 << 11) | 20) & 0xFu; }
#define XB_SPIN(cond, bar) do { unsigned _sp = 0; while (cond) { __builtin_amdgcn_s_sleep(1); \
    if ((++_sp & 255u) == 0u) { if (xb_ld(&(bar)[XB_TMO])) break; if (_sp > XB_SPIN_CAP) { atomicAdd(&(bar)[XB_TMO], 1u); break; } } } } while (0)

struct XcdBarrier {
    int wv;
    unsigned* bar; unsigned x;
    volatile LAS unsigned* st;
};

__device__ __forceinline__ XcdBarrier xcd_barrier_post(unsigned* bar, volatile LAS unsigned* st, int wv) {
    XcdBarrier b; b.bar = bar; b.x = xb_xcc_id(); b.st = st; b.wv = wv;
    if (wv == 0 && pg8::fresh_lane() == 0) (void)xb_add(&bar[XB_XCNT(b.x)], 1u);
    return b;
}
__device__ __forceinline__ void xcd_barrier_complete(unsigned* bar, unsigned x, unsigned& nloc, unsigned& nx) {
    const unsigned G = gridDim.x * gridDim.y * gridDim.z;
    unsigned sum, cnt, mine, sp = 0u;
    for (;;) {
        sum = 0u; cnt = 0u; mine = 0u;
#pragma unroll
        for (unsigned j = 0; j < 16; ++j) { const unsigned c = xb_ld(&bar[XB_XCNT(j)]); sum += c; cnt += (c > 0u) ? 1u : 0u; mine = (j == x) ? c : mine; }
        if (sum == G) break;
        __builtin_amdgcn_s_sleep(1);
        if ((++sp & 255u) == 0u) { if (xb_ld(&bar[XB_TMO])) break; if (sp > XB_SPIN_CAP) { atomicAdd(&bar[XB_TMO], 1u); break; } }
    }
    nloc = mine > 0u ? mine : 1u; nx = cnt > 0u ? cnt : 1u;
}

__device__ __forceinline__ void xcd_barrier(const XcdBarrier& b) {
    asm volatile("s_waitcnt vmcnt(0)" ::: "memory");
    __syncthreads();
    if (b.wv == 0 && pg8::fresh_lane() == 0) {
        unsigned* bar = b.bar;
        __builtin_amdgcn_s_waitcnt(0);
        unsigned nloc = b.st[0], nx = b.st[1];
        if (nloc == 0u) { xcd_barrier_complete(bar, b.x, nloc, nx); b.st[0] = nloc; b.st[1] = nx; }
        const unsigned old = xb_add(&bar[XB_XSUB(b.x)], 1u);
        const unsigned gen = old / nloc;
        if (old + 1u == (gen + 1u) * nloc) {
            __builtin_amdgcn_fence(__ATOMIC_RELEASE, "agent");
            asm volatile("s_waitcnt vmcnt(0)" ::: "memory");
            const unsigned og = xb_add(&bar[XB_TOP], 1u);
            const unsigned tg = og / nx;
            if (og + 1u == (tg + 1u) * nx) xb_add(&bar[XB_TOPGEN], 1u);
            else XB_SPIN(xb_ld(&bar[XB_TOPGEN]) == tg, bar);
            __builtin_amdgcn_fence(__ATOMIC_ACQUIRE, "agent");
            xb_add(&bar[XB_XGEN(b.x)], 1u);
            asm volatile("s_waitcnt vmcnt(0)" ::: "memory");
        } else {
            XB_SPIN(xb_ld(&bar[XB_XGEN(b.x)]) == gen, bar);
            __builtin_amdgcn_fence(__ATOMIC_ACQUIRE, "agent");
            asm volatile("s_waitcnt vmcnt(0)" ::: "memory");
        }
    }
    __syncthreads();
}

template <class Epi>
__device__ __forceinline__ void run_gemm(LAS unsigned char* lds, const bf16* A, const bf16* Bt, int N, int K, const Epi& E, const int wv) {
    pg8::Gemm g{A, Bt, T, N, K}; pg8::StaticOrder S; S.init(T, N, (int)gridDim.x, (int)blockIdx.x);
    pg8::gemm_phase<Epi, pg8::StaticOrder, true, true>(lds, g, S, E, wv);
}

__global__ void __launch_bounds__(NTHREADS, 2) yoco_fwd(Params p) {
    extern __shared__ __attribute__((aligned(16))) unsigned char lds_raw[];
    LAS unsigned char* lds = (LAS unsigned char*)lds_raw;
    cg::grid_group grid = cg::this_grid();
    volatile LAS unsigned* bst = (volatile LAS unsigned*)(lds + LDS_BYTES - 16);
    const int WV = __builtin_amdgcn_readfirstlane((int)threadIdx.x >> 6);
    if (WV == 0 && pg8::fresh_lane() < 4) bst[pg8::fresh_lane()] = 0u;
    if (blockIdx.x == 0) { unsigned* cw = (unsigned*)(p.ws + WS_BAR); for (int i = (WV << 6) | pg8::fresh_lane(); i < 16384 / 4; i += NTHREADS) cw[i] = 0u; }
    { unsigned* xb = (unsigned*)(p.ws + WS_XBUF); for (int i = blockIdx.x * NTHREADS + ((WV << 6) | pg8::fresh_lane()); i < T * 4; i += gridDim.x * NTHREADS) xb[i] = 0u; }
    asm volatile("s_waitcnt vmcnt(0)" ::: "memory");
    grid.sync();
    const XcdBarrier bar = xcd_barrier_post((unsigned*)(p.ws + WS_BAR), bst, WV);
#define GRID_SYNC() xcd_barrier(bar)
    unsigned char* ws = p.ws;
    bf16* HNF = (bf16*)(ws + WS_HNF); bf16* HID = (bf16*)(ws + WS_HID); float* PART = (float*)(ws + WS_PART);
    const float* cs = (const float*)(ws + WS_COS); const float* sn = (const float*)(ws + WS_SIN);

    prologue(p, lds, WV);
    GRID_SYNC();

#define PSS(k) pg8::PanelSS{(unsigned*)(ws + WS_XBUF), (unsigned)(k)}
#define FFN_BLOCK(lj, LAST, k) do { \
        run_gemm(lds, HNF, (const bf16*)(ws + WS_WGU) + (size_t)(lj) * WGU_ELEMS, 2 * FF, D, pg8::EpiSwiGLU{HID, FF, PART}, WV); \
        GRID_SYNC(); \
        run_gemm(lds, HID, (const bf16*)(ws + WS_WD) + (size_t)(lj) * WD_ELEMS, D, FF, pg8::EpiRes<LAST>{HNF, p.in[3] + (lj) * D, 0.5f, PART, p.out, PSS(k), lds + 131072}, WV); \
        if (!(LAST)) GRID_SYNC(); \
    } while (0)

    FFN_BLOCK(0, false, 1);
    run_gemm(lds, HNF, (const bf16*)(ws + WS_WIN), 4096, D, pg8::EpiGelu{(bf16*)(ws + WS_U), (bf16*)(ws + WS_V), (float*)(ws + WS_VSTAT), PART}, WV);
    GRID_SYNC();
    gate_phase(p, lds, WV);
    GRID_SYNC();
    run_gemm(lds, (const bf16*)(ws + WS_U), (const bf16*)(ws + WS_WOUT), D, 2048, pg8::EpiRes<false>{HNF, p.in[8], 1.0f, PART, p.out, PSS(2), lds + 131072}, WV);
    GRID_SYNC();
    FFN_BLOCK(1, false, 3);
    run_gemm(lds, HNF, (const bf16*)(ws + WS_WDKV), 512, D, pg8::EpiDkv{(bf16*)(ws + WS_C), (float*)(ws + WS_CPART), (bf16*)(ws + WS_KR), cs, sn, PART}, WV);
    GRID_SYNC();
    run_gemm(lds, (const bf16*)(ws + WS_C), (const bf16*)(ws + WS_WUKV), 2048, 256, pg8::EpiUkv{(bf16*)(ws + WS_KN), (bf16*)(ws + WS_VV), (const float*)(ws + WS_CPART)}, WV);
    FFN_BLOCK(2, false, 4);
    run_gemm(lds, HNF, (const bf16*)(ws + WS_WDQ), 512, D, pg8::EpiStat{(bf16*)(ws + WS_QC), 512, (float*)(ws + WS_QPART), 8, PART}, WV);
    GRID_SYNC();
    run_gemm(lds, (const bf16*)(ws + WS_QC), (const bf16*)(ws + WS_WUQ), 1536, 512, pg8::EpiUq{(bf16*)(ws + WS_Q), (const float*)(ws + WS_QPART), cs, sn}, WV);
    GRID_SYNC();
    att_phase(p, lds, WV);
    GRID_SYNC();
    run_gemm(lds, (const bf16*)(ws + WS_O), (const bf16*)(ws + WS_WO), D, D, pg8::EpiRes<false>{HNF, p.in[8] + D, 1.0f, PART, p.out, PSS(5), lds + 131072}, WV);
    GRID_SYNC();
    FFN_BLOCK(3, true, 6);
#undef PSS
#undef FFN_BLOCK
}

extern "C" void kernel_launch(void* const* d_in, const int* in_sizes, int n_in, void* d_out, int out_size, void* d_ws, size_t ws_size, hipStream_t stream) {
    static int grid = 0;
    if (grid == 0) {
        if (n_in != 23 || out_size != T * D || ws_size < WS_END) { fprintf(stderr, "kernel_launch: unexpected sizes n_in %d out %d ws %zu\n", n_in, out_size, ws_size); grid = -1; return; }
        int dev = 0, cus = 0, per_cu = 0;
        hipGetDevice(&dev);
        hipDeviceGetAttribute(&cus, hipDeviceAttributeMultiprocessorCount, dev);
        hipFuncSetAttribute((const void*)yoco_fwd, hipFuncAttributeMaxDynamicSharedMemorySize, LDS_BYTES);
        hipOccupancyMaxActiveBlocksPerMultiprocessor(&per_cu, (const void*)yoco_fwd, NTHREADS, LDS_BYTES);
        if (per_cu < 1) per_cu = 1;
        grid = cus * per_cu;
        if (grid > 256) grid = 256;
        (void)hipGetLastError();
    }
    if (grid < 0) return;
    Params p{};
    for (int i = 0; i < 23; ++i) p.in[i] = (const float*)d_in[i];
    p.out = (float*)d_out; p.ws = (unsigned char*)d_ws;
    void* args[] = {&p};
    hipError_t e = hipLaunchCooperativeKernel((const void*)yoco_fwd, dim3(grid), dim3(NTHREADS), args, LDS_BYTES, stream);
    if (e != hipSuccess) fprintf(stderr, "cooperative launch failed: %s (grid %d)\n", hipGetErrorString(e), grid);
}
```
